# Optimizing an MI355X kernel written in HIP

```python
import jax, jax.numpy as jnp
from jax import lax
import numpy as np

D_MODEL = 1024
BATCH = 4
SEQ = 4096
DEPTH = 2

GRID_W = 64
HEAD_DIM = 64
QBLK = 128
EPS = 1e-6
NEG_INF = -1e30
ROPE_THETA = 10000.0

A_HEADS = 4
A_WIN_R = 8
A_WIN_C = 16
A_COL_BLK = 16
A_KEY_COLS = 32
B_HEADS = 4
B_KV_HEADS = 2
B_WINDOW = 128
T5_BUCKETS = 32
T5_MAX_DIST = 128
C_HEADS = 4
C_KV_HEADS = 2
D_HEADS = 4
D_Q_LORA = 256
D_KV_LORA = 128
D_NOPE = 64
D_ROPE = 32
D_V = 64

N_BRANCH = 4
BRANCH_W = 256
D_FF = ((8 * D_MODEL + 3 * 256 - 1) // (3 * 256)) * 256

A_W = A_HEADS * HEAD_DIM
B_QW = B_HEADS * HEAD_DIM
B_KVW = B_KV_HEADS * HEAD_DIM
C_QW = C_HEADS * HEAD_DIM
C_KVW = C_KV_HEADS * HEAD_DIM
IN_SPLITS = (A_W, A_W, A_W, B_QW, B_KVW, B_KVW, C_QW, C_KVW, C_KVW,
             D_Q_LORA, D_KV_LORA, D_ROPE, N_BRANCH * D_MODEL)
IN_WIDTH = sum(IN_SPLITS)

kernel_name = 'hybrid_gated_encoder_block'


def rms_norm(x, g):
    xf = x.astype(jnp.float32)
    y = xf * lax.rsqrt(jnp.mean(xf * xf, axis=-1, keepdims=True) + EPS)
    return (y * g.astype(jnp.float32)).astype(x.dtype)


def rope_rotate(x, pos):
    d = x.shape[-1]
    half = d // 2
    inv_freq = 1.0 / (ROPE_THETA ** (jnp.arange(half, dtype=jnp.float32) * (2.0 / d)))
    ang = pos[:, None] * inv_freq[None, :]
    cos = jnp.cos(ang)[:, None, :]
    sin = jnp.sin(ang)[:, None, :]
    xf = x.astype(jnp.float32)
    x1, x2 = xf[..., :half], xf[..., half:]
    return jnp.concatenate([x1 * cos - x2 * sin, x2 * cos + x1 * sin], axis=-1).astype(x.dtype)


def axial_rope(x, row_pos, col_pos):
    h = x.shape[-1] // 2
    return jnp.concatenate([rope_rotate(x[..., :h], row_pos), rope_rotate(x[..., h:], col_pos)], axis=-1)


def t5_buckets(rel):
    nb = T5_BUCKETS // 2
    max_exact = nb // 2
    ret = (rel > 0).astype(np.int32) * nb
    n = np.abs(rel)
    large = max_exact + (np.log(np.maximum(n, 1) / max_exact) / np.log(T5_MAX_DIST / max_exact)
                         * (nb - max_exact)).astype(np.int32)
    large = np.minimum(large, nb - 1)
    return ret + np.where(n < max_exact, n, large)


def neighborhood_attention(q, k, v, rpb):
    b, s, h, d = q.shape
    rows = s // GRID_W
    kr = min(A_WIN_R, rows)
    ncb = GRID_W // A_COL_BLK
    nk = kr * A_KEY_COLS
    r = np.arange(rows)
    rs = np.clip(r - A_WIN_R // 2, 0, rows - kr)
    key_rows = rs[:, None] + np.arange(kr)[None, :]
    col0 = np.clip(np.arange(ncb) * A_COL_BLK - A_WIN_C // 2, 0, GRID_W - A_KEY_COLS)
    key_cols = col0[:, None] + np.arange(A_KEY_COLS)[None, :]
    idx = key_rows[:, None, :, None] * GRID_W + key_cols[None, :, None, :]
    flat = jnp.asarray(idx.reshape(-1))
    kg = jnp.take(k, flat, axis=1).reshape(b, rows, ncb, nk, h, d)
    vg = jnp.take(v, flat, axis=1).reshape(b, rows, ncb, nk, h, d)
    qb = q.reshape(b, rows, ncb, A_COL_BLK, h, d)
    q_cols = np.arange(ncb)[:, None] * A_COL_BLK + np.arange(A_COL_BLK)[None, :]
    cs = np.clip(q_cols - A_WIN_C // 2, 0, GRID_W - A_WIN_C)
    kc = key_cols[:, None, :]
    col_ok = (kc >= cs[:, :, None]) & (kc < cs[:, :, None] + A_WIN_C)
    mask = np.broadcast_to(col_ok[:, :, None, :], (ncb, A_COL_BLK, kr, A_KEY_COLS)).reshape(ncb, A_COL_BLK, nk)
    dr = key_rows - r[:, None] + (A_WIN_R - 1)
    dc = np.clip(kc - q_cols[:, :, None], -(A_WIN_C - 1), A_WIN_C - 1) + (A_WIN_C - 1)
    bias = rpb[:, dr[:, None, None, :, None], dc[None, :, :, None, :]]
    bias = bias.reshape(h, rows, ncb, A_COL_BLK, nk).transpose(1, 2, 0, 3, 4)
    sc = jnp.einsum('brjqhd,brjkhd->brjhqk', qb, kg, preferred_element_type=jnp.float32) * (d ** -0.5)
    sc = jnp.where(mask[None, None, :, None], sc + bias.astype(jnp.float32), NEG_INF)
    p = jax.nn.softmax(sc, axis=-1).astype(v.dtype)
    o = jnp.einsum('brjhqk,brjkhd->brjqhd', p, vg)
    return o.reshape(b, s, h * d)


def window_sink_attention(q, k, v, sink, t5_table):
    b, s, hkv, g, d = q.shape
    nb = s // QBLK
    kl = QBLK + 2 * B_WINDOW
    kp = jnp.pad(k, ((0, 0), (B_WINDOW, B_WINDOW), (0, 0), (0, 0)))
    vp = jnp.pad(v, ((0, 0), (B_WINDOW, B_WINDOW), (0, 0), (0, 0)))
    idx = np.arange(nb)[:, None] * QBLK + np.arange(kl)[None, :]
    flat = jnp.asarray(idx.reshape(-1))
    kb = jnp.take(kp, flat, axis=1).reshape(b, nb, kl, hkv, d)
    vb = jnp.take(vp, flat, axis=1).reshape(b, nb, kl, hkv, d)
    kpos = idx - B_WINDOW
    qpos = np.arange(nb)[:, None] * QBLK + np.arange(QBLK)[None, :]
    rel = kpos[:, None, :] - qpos[:, :, None]
    valid = (np.abs(rel) <= B_WINDOW) & (kpos[:, None, :] >= 0) & (kpos[:, None, :] < s)
    bucket = t5_buckets(rel[0])
    bias = t5_table[bucket].transpose(2, 0, 1).reshape(hkv, g, QBLK, kl).astype(jnp.float32)
    qb = q.reshape(b, nb, QBLK, hkv, g, d)
    sc = jnp.einsum('bnqhgd,bnkhd->bnhgqk', qb, kb, preferred_element_type=jnp.float32) * (d ** -0.5)
    sc = jnp.where(valid[None, :, None, None], sc + bias[None, None], NEG_INF)
    sk = sink.astype(jnp.float32).reshape(hkv, g)[None, None, :, :, None, None]
    m = jnp.maximum(jnp.max(sc, axis=-1, keepdims=True), sk)
    e = jnp.exp(sc - m)
    p = e / (jnp.sum(e, axis=-1, keepdims=True) + jnp.exp(sk - m))
    o = jnp.einsum('bnhgqk,bnkhd->bnqhgd', p.astype(v.dtype), vb)
    return o.reshape(b, s, hkv * g * d)


def dense_block_attention(q, k, v, scale):
    b, s, hkv, g, dq = q.shape
    dv = v.shape[-1]
    nb = s // QBLK
    qb = q.reshape(b, nb, QBLK, hkv, g, dq).transpose(1, 0, 2, 3, 4, 5)

    def one_block(qblk):
        sc = jnp.einsum('bqhgd,bkhd->bhgqk', qblk, k, preferred_element_type=jnp.float32) * scale
        p = jax.nn.softmax(sc, axis=-1).astype(v.dtype)
        return jnp.einsum('bhgqk,bkhd->bqhgd', p, v)

    o = lax.map(one_block, qb)
    return o.transpose(1, 0, 2, 3, 4, 5).reshape(b, s, hkv * g * dv)


def hybrid_mixer(xn, w_in, a_rpb, b_sink, t5_table, c_qn, c_kn, d_qn, d_kvn, d_wq, d_wkv, w_branch, w_out):
    b, s, _ = xn.shape
    proj = xn @ w_in
    offsets = np.cumsum(IN_SPLITS)[:-1].tolist()
    (aq, ak, av, bq, bk, bv, cq, ck, cv, dcq, dckv, dkr, gate_logits) = jnp.split(proj, offsets, axis=-1)
    t = jnp.arange(s)
    pos = t.astype(jnp.float32)
    row_pos = (t // GRID_W).astype(jnp.float32)
    col_pos = (t % GRID_W).astype(jnp.float32)

    o_a = neighborhood_attention(aq.reshape(b, s, A_HEADS, HEAD_DIM), ak.reshape(b, s, A_HEADS, HEAD_DIM),
                                 av.reshape(b, s, A_HEADS, HEAD_DIM), a_rpb)
    o_b = window_sink_attention(bq.reshape(b, s, B_KV_HEADS, B_HEADS // B_KV_HEADS, HEAD_DIM),
                                bk.reshape(b, s, B_KV_HEADS, HEAD_DIM), bv.reshape(b, s, B_KV_HEADS, HEAD_DIM),
                                b_sink, t5_table)
    qc = axial_rope(rms_norm(cq.reshape(b, s, C_HEADS, HEAD_DIM), c_qn), row_pos, col_pos)
    kc = axial_rope(rms_norm(ck.reshape(b, s, C_KV_HEADS, HEAD_DIM), c_kn), row_pos, col_pos)
    o_c = dense_block_attention(qc.reshape(b, s, C_KV_HEADS, C_HEADS // C_KV_HEADS, HEAD_DIM), kc,
                                cv.reshape(b, s, C_KV_HEADS, HEAD_DIM), HEAD_DIM ** -0.5)
    qd = (rms_norm(dcq, d_qn) @ d_wq).reshape(b, s, D_HEADS, D_NOPE + D_ROPE)
    qd = jnp.concatenate([qd[..., :D_NOPE], rope_rotate(qd[..., D_NOPE:], pos)], axis=-1)
    kvd = (rms_norm(dckv, d_kvn) @ d_wkv).reshape(b, s, D_HEADS, D_NOPE + D_V)
    k_rope = rope_rotate(dkr.reshape(b, s, 1, D_ROPE), pos)
    kd = jnp.concatenate([kvd[..., :D_NOPE], jnp.broadcast_to(k_rope, (b, s, D_HEADS, D_ROPE))], axis=-1)
    o_d = dense_block_attention(qd[:, :, :, None, :], kd, kvd[..., D_NOPE:], (D_NOPE + D_ROPE) ** -0.5)

    branches = jnp.stack([o_a, o_b, o_c, o_d], axis=2)
    y = jnp.einsum('bsnc,ncd->bsnd', branches, w_branch)
    gates = jax.nn.sigmoid(gate_logits.astype(jnp.float32)).astype(xn.dtype).reshape(b, s, N_BRANCH, D_MODEL)
    merged = jnp.sum(gates * y, axis=2)
    return merged @ w_out


def setup_inputs(seed: int = 0) -> dict:
    key = jax.random.key(seed)
    ks = jax.random.split(key, 20)
    f32 = jnp.float32

    def nrm(k, shape, scale):
        return jax.random.normal(k, shape, f32) * scale

    def gain(k, shape):
        return 1.0 + 0.05 * jax.random.normal(k, shape, f32)

    return {
        'x': nrm(ks[0], (BATCH, SEQ, D_MODEL), 1.0),
        'w_in': nrm(ks[1], (DEPTH, D_MODEL, IN_WIDTH), D_MODEL ** -0.5),
        'a_rpb': nrm(ks[2], (DEPTH, A_HEADS, 2 * A_WIN_R - 1, 2 * A_WIN_C - 1), 0.5),
        'b_sink': nrm(ks[3], (DEPTH, B_HEADS), 1.0),
        't5_bias': nrm(ks[4], (T5_BUCKETS, B_HEADS), 0.5),
        'c_q_norm': gain(ks[5], (DEPTH, HEAD_DIM)),
        'c_k_norm': gain(ks[6], (DEPTH, HEAD_DIM)),
        'd_q_norm': gain(ks[7], (DEPTH, D_Q_LORA)),
        'd_kv_norm': gain(ks[8], (DEPTH, D_KV_LORA)),
        'd_w_q_up': nrm(ks[9], (DEPTH, D_Q_LORA, D_HEADS * (D_NOPE + D_ROPE)), D_Q_LORA ** -0.5),
        'd_w_kv_up': nrm(ks[10], (DEPTH, D_KV_LORA, D_HEADS * (D_NOPE + D_V)), D_KV_LORA ** -0.5),
        'w_branch': nrm(ks[11], (DEPTH, N_BRANCH, BRANCH_W, D_MODEL), BRANCH_W ** -0.5),
        'w_out': nrm(ks[12], (DEPTH, D_MODEL, D_MODEL), D_MODEL ** -0.5),
        'ln_pre_mix': gain(ks[13], (DEPTH, D_MODEL)),
        'ln_post_mix': gain(ks[14], (DEPTH, D_MODEL)),
        'ln_pre_ffn': gain(ks[15], (DEPTH, D_MODEL)),
        'ln_post_ffn': gain(ks[16], (DEPTH, D_MODEL)),
        'ffn_w_gu': nrm(ks[17], (DEPTH, D_MODEL, 2 * D_FF), D_MODEL ** -0.5),
        'ffn_w_down': nrm(ks[18], (DEPTH, D_FF, D_MODEL), D_FF ** -0.5),
    }


def reference(x, w_in, a_rpb, b_sink, t5_bias, c_q_norm, c_k_norm, d_q_norm, d_kv_norm, d_w_q_up, d_w_kv_up,
              w_branch, w_out, ln_pre_mix, ln_post_mix, ln_pre_ffn, ln_post_ffn, ffn_w_gu, ffn_w_down):
    for l in range(DEPTH):
        h = rms_norm(x, ln_pre_mix[l])
        m = hybrid_mixer(h, w_in[l], a_rpb[l], b_sink[l], t5_bias, c_q_norm[l], c_k_norm[l], d_q_norm[l],
                         d_kv_norm[l], d_w_q_up[l], d_w_kv_up[l], w_branch[l], w_out[l])
        x = x + rms_norm(m, ln_post_mix[l])
        h = rms_norm(x, ln_pre_ffn[l])
        gu = h @ ffn_w_gu[l]
        f = (jax.nn.silu(gu[..., :D_FF]) * gu[..., D_FF:]) @ ffn_w_down[l]
        x = x + rms_norm(f, ln_post_ffn[l])
    return x
```

```cpp
#include <hip/hip_runtime.h>
#include <hip/hip_cooperative_groups.h>
#include <cstdio>
#include <cstdint>
namespace cg = cooperative_groups;

#ifndef MK_PER_PHASE
#define MK_PER_PHASE 0
#endif
#ifndef MK_CG_FIRST
#define MK_CG_FIRST 0
#endif
#ifndef MK_CG_BARRIER
#define MK_CG_BARRIER 0
#endif

#define LAS __attribute__((address_space(3)))
#define GAS __attribute__((address_space(1)))
typedef unsigned short bf16_t;
typedef short bf16x8 __attribute__((ext_vector_type(8)));
typedef short s16x4 __attribute__((ext_vector_type(4)));
typedef float f32x4 __attribute__((ext_vector_type(4)));
typedef float f32x16 __attribute__((ext_vector_type(16)));
typedef unsigned u32x4 __attribute__((ext_vector_type(4)));
typedef unsigned u32x2 __attribute__((ext_vector_type(2)));

constexpr int DM = 1024, SEQ = 4096, NB = 4, M = NB * SEQ, DEPTH = 2;
constexpr int NIN = 6304, NPS = 2304, NGT = 4096, NPROJ = NPS + NGT, DFF = 2816, NGU = 2 * DFF;
constexpr float EPS = 1e-6f;
constexpr float LOG2E = 1.4426950408889634f;
constexpr int C_AQ = 0, C_AK = 256, C_AV = 512, C_BQ = 768, C_BK = 1024, C_BV = 1152, C_CQ = 1280, C_CK = 1536, C_CV = 1664, C_DCQ = 1792, C_DCKV = 2048, C_DKR = 2176;
constexpr size_t MiB = 1u << 20;
constexpr size_t WS_CTL = 0, CTL_BYTES = 1 * MiB;
constexpr size_t WS_RSQ = 252 * MiB;
constexpr size_t WS_TAB = 1 * MiB;
constexpr size_t WS_WIN = 2 * MiB;
constexpr size_t WS_WG8 = WS_WIN + (size_t)NPS * DM * 2;
constexpr size_t WS_WDUP = WS_WIN + (size_t)NPROJ * DM * 2;
constexpr size_t WS_WBR = WS_WDUP + (size_t)1024 * 384 * 2;
constexpr size_t WS_WOUT = WS_WBR + (size_t)4 * 1024 * 256 * 2;
constexpr size_t WS_HS = 20 * MiB;
constexpr size_t WS_QD = WS_HS, WS_KD = WS_HS + 12 * MiB, WS_VD = WS_HS + 24 * MiB;
constexpr size_t WS_PS = 52 * MiB;
constexpr size_t WS_GT = 124 * MiB;
constexpr size_t WS_MO = WS_PS;
constexpr size_t WS_ACT = WS_PS;
constexpr size_t WS_FO = 144 * MiB;
constexpr size_t WS_XS = 176 * MiB;
constexpr size_t WS_WGU = 232 * MiB;
constexpr size_t WS_WDN = 243 * MiB;
constexpr size_t WS_RSX = 253 * MiB;
constexpr size_t WS_END = 254 * MiB;
static_assert(WS_WOUT + (size_t)DM * DM * 2 <= WS_HS, "ws map");
static_assert(WS_ACT + (size_t)M * DFF * 2 <= WS_FO && WS_FO + (size_t)M * DM * 2 <= WS_WGU && WS_WGU + (size_t)NGU * DM * 2 <= WS_WDN && WS_WDN + (size_t)DM * DFF * 2 <= WS_END, "ws map 2");
constexpr int CW_BAR = 4096;

__device__ __forceinline__ unsigned cvt_pk_bf16(float lo, float hi) { unsigned r; asm volatile("v_cvt_pk_bf16_f32 %0, %1, %2" : "=v"(r) : "v"(lo), "v"(hi)); return r; }
__device__ __forceinline__ unsigned f2bf(float f) { unsigned u = __builtin_bit_cast(unsigned, f); return (u + 0x7fffu + ((u >> 16) & 1u)) >> 16; }
__device__ __forceinline__ float bf_lo(unsigned w) { return __uint_as_float(w << 16); }
__device__ __forceinline__ float bf_hi(unsigned w) { return __uint_as_float(w & 0xffff0000u); }
__device__ __forceinline__ float bf2f(bf16_t h) { return __uint_as_float(((unsigned)h) << 16); }
__device__ __forceinline__ float sigmoidf_(float x) { return __builtin_amdgcn_rcpf(1.0f + __builtin_amdgcn_exp2f(-x * LOG2E)); }
__device__ __forceinline__ int lane_id() { unsigned z = 0u; asm volatile("" : "+v"(z)); return (int)__builtin_amdgcn_mbcnt_hi(~0u, __builtin_amdgcn_mbcnt_lo(~0u, z)); }
__device__ __forceinline__ int cur_tid(int wave) { return wave * 64 + lane_id(); }
__device__ __forceinline__ int cur_bid() { int b = blockIdx.x; asm volatile("" : "+s"(b)); return b; }
__device__ __forceinline__ float wave_sum(float v) {
#pragma unroll
    for (int o = 1; o < 64; o <<= 1) v += __shfl_xor(v, o);
    return v;
}

namespace pg8 {
constexpr int BM = 256, BK = 64, HALF = 128, HTB = HALF * BK * 2, STAGE_BYTES = 8 * HTB, NXCD = 8, WGM = 8;
__host__ __device__ __forceinline__ int lds_byte(int r, int c) { const int st = (r >> 4) * 2 + (c >> 5), rr = r & 15, cc = c & 31, ob = rr * 64 + cc * 2; return st * 1024 + (ob ^ (((ob >> 9) & 1) << 5)); }
__host__ __device__ __forceinline__ void stage_rc(int b, int& R, int& C) { const int st = b / 1024, sb = b % 1024, swz = sb ^ (((sb >> 9) & 1) << 5); R = (st >> 1) * 16 + swz / 64; C = (st & 1) * 32 + (swz % 64) / 2; }
__host__ __device__ __forceinline__ int perm32(int rho) { const int n = rho >> 4, i = rho & 15; return 8 * (i >> 2) + 4 * n + (i & 3); }

struct Unit { const char* a; const char* b; int pm, pn, aux, nt; };
__device__ __forceinline__ size_t gate_unit_off(int pm, int pn, int n) { return ((size_t)((pm * 4 + pn) * 4 + n)) << 17; }
__device__ __forceinline__ void tile_of(int L, int nM, int nN, int& pm, int& pn) {
    const int nwg = nM * nN; int wgid = L;
    { const int q = nwg / NXCD, r = nwg % NXCD, xcd = wgid % NXCD, off = wgid / NXCD; wgid = (xcd < r ? xcd * (q + 1) : r * (q + 1) + (xcd - r) * q) + off; }
    const int nig = WGM * nN, gid = wgid / nig, fm = gid * WGM, gsz = (nM - fm) < WGM ? (nM - fm) : WGM;
    pm = fm + ((wgid % nig) % gsz); pn = (wgid % nig) / gsz;
}
struct SchedTiles {
    const bf16_t* A; const bf16_t* Bt; int lda, ldb, nM, nN, G, c, pn_off = 0, slot0 = 0;
    __device__ __forceinline__ bool next(int i, Unit& u) const {
        const long L = (long)i * G + c; if (L >= (long)nM * nN) return false;
        int pm, pn; tile_of((int)L, nM, nN, pm, pn);
        u.pm = pm; u.pn = pn + pn_off; u.aux = slot0 + i; u.a = (const char*)(A + (size_t)pm * BM * lda); u.b = (const char*)(Bt + (size_t)pn * BM * ldb); return true;
    }
};
struct SchedGateBal {
    const bf16_t* A; const bf16_t* Bt; int lda, ldb, G, c, pn_off, slot0;
    __device__ __forceinline__ bool next(int i, Unit& u) const {
        long L;
        if (G == 256) { if (i < 3) L = (long)i * 256 + c; else if (i == 3) { if (c < 64) return false; L = 768 + (c - 64); } else if (i == 4) { if (c < 64 || c >= 128) return false; L = 960 + (c - 64); } else return false; }
        else { L = (long)i * G + c; if (L >= 1024) return false; }
        int pm, pn; tile_of((int)L, 64, 16, pm, pn);
        u.pm = pm; u.pn = pn + pn_off; u.aux = slot0 + i; u.a = (const char*)(A + (size_t)pm * BM * lda); u.b = (const char*)(Bt + (size_t)pn * BM * ldb); return true;
    }
};
constexpr int RSX_LDS = 131072 + 2048;
template <class Sched> __device__ __forceinline__ void fill_rsx_lds(LAS unsigned char* lds, const int tid, const Sched& S, const float* rsx, const int nmax) {
    const int wv = __builtin_amdgcn_readfirstlane(tid >> 6), lane = tid & 63;
    for (int i = wv >> 2; i < nmax; i += 2) { Unit u; if (S.next(i, u)) {
        const int slot = __builtin_amdgcn_readfirstlane(u.aux), pm = __builtin_amdgcn_readfirstlane(u.pm);
        __builtin_amdgcn_global_load_lds((const unsigned*)(rsx + pm * BM + (wv & 3) * 64 + lane), (LAS unsigned*)(lds + RSX_LDS + slot * 1024 + (wv & 3) * 256), 4, 0, 0); } }
}
struct SchedDup {
    const bf16_t* PS; const bf16_t* Wd; int G, c;
    __device__ __forceinline__ bool next(int i, Unit& u) const {
        const long L = (long)i * G + c; if (L >= 256) return false;
        int pm, pn; tile_of((int)L, 64, 4, pm, pn); const bool q = pn < 2;
        u.pm = pm; u.pn = pn; u.aux = 0; u.nt = q ? 4 : 2;
        u.a = (const char*)(PS + (size_t)pm * BM * NPS + (q ? C_DCQ : C_DCKV)); u.b = (const char*)(Wd + (size_t)pn * BM * 384 + (q ? 0 : 256)); return true;
    }
};
struct SchedBranch {
    const bf16_t* PS; const bf16_t* Wbr; int G, c;
    __device__ __forceinline__ bool next(int i, Unit& u) const {
        const int ti = i >> 2, n = i & 3; const long L = (long)ti * G + c; if (L >= 256) return false;
        int pm, pn; tile_of((int)L, 64, 4, pm, pn);
        const int colofs = (n == 0) ? C_AQ : (n == 1) ? C_BQ : (n == 2) ? C_CQ : C_DCQ;
        u.pm = pm; u.pn = pn; u.aux = n; u.a = (const char*)(PS + (size_t)pm * BM * NPS + colofs); u.b = (const char*)(Wbr + ((size_t)n * 1024 + pn * BM) * 256); return true;
    }
};

typedef int v8i __attribute__((ext_vector_type(8)));
typedef int v4i __attribute__((ext_vector_type(4)));
template <class Epi, class Sched, bool ALIGN_EPI, int K, int lda, int ldb, bool FP8 = false, bool VARNT = false>
__device__ __forceinline__ void gemm_phase(LAS unsigned char* lds, const int wid, const Sched& S, const Epi& E) {
    const int lane = lane_id(), tid = wid * 64 + lane, wr = wid >> 2, wc = wid & 3, fr = lane & 15, fq = lane >> 4;
    constexpr int nt_c = K / BK;
    unsigned voffA[2], voffB[2];
#pragma unroll
    for (int i = 0; i < 2; ++i) { int R, C; stage_rc(tid * 16 + i * 8192, R, C); const int Rb = Epi::PERM ? ((R & ~31) + perm32(R & 31)) : R;
        voffA[i] = (unsigned)(R * lda + C) * 2u; voffB[i] = (unsigned)(Rb * ldb + C) * 2u; }
    const size_t kstep = (size_t)(BK * 2);
    const size_t hstepA = (size_t)HALF * lda * 2, hstepB = (size_t)HALF * ldb * 2;
    const unsigned ldsw = (unsigned)wid * 1024u;
    const unsigned basel = (unsigned)lds_byte(fr, fq * 8); const unsigned aoffs = (unsigned)wr * 8192u, boffs = (unsigned)wc * 4096u;
#define PG8_SA(b, h) (((b) * 2 + (h)) * HTB)
#define PG8_SB(b, h) ((4 + (b) * 2 + (h)) * HTB)
#define PG8_STAGE(bufoff, gbase, voff) do { _Pragma("unroll") for (int _i = 0; _i < 2; ++_i) \
        __builtin_amdgcn_global_load_lds((const unsigned*)((const char*)(gbase) + (voff)[_i]), (LAS unsigned*)(lds + (bufoff) + ldsw + _i * 8192), 16, 0, 0); } while (0)
#define PG8_CAT(lo_, hi_) __builtin_shufflevector(lo_, hi_, 0, 1, 2, 3, 4, 5, 6, 7)
#define PG8_LDA(dst, b, h) do { unsigned ad_ = basel + (aoffs + (unsigned)PG8_SA(b, h)); asm volatile("" : "+v"(ad_)); _Pragma("unroll") for (int m = 0; m < 4; ++m) { \
        if constexpr (FP8) dst##8[m] = PG8_CAT(*(const LAS v4i*)(lds + ad_ + m * 2048), *(const LAS v4i*)(lds + ad_ + m * 2048 + 1024)); \
        else { _Pragma("unroll") for (int k = 0; k < 2; ++k) dst[m][k] = *(const LAS bf16x8*)(lds + ad_ + m * 2048 + k * 1024); } } } while (0)
#define PG8_LDB(dst, b, h) do { unsigned ad_ = basel + (boffs + (unsigned)PG8_SB(b, h)); asm volatile("" : "+v"(ad_)); _Pragma("unroll") for (int n = 0; n < 2; ++n) { \
        if constexpr (FP8) dst##8[n] = PG8_CAT(*(const LAS v4i*)(lds + ad_ + n * 2048), *(const LAS v4i*)(lds + ad_ + n * 2048 + 1024)); \
        else { _Pragma("unroll") for (int k = 0; k < 2; ++k) dst[n][k] = *(const LAS bf16x8*)(lds + ad_ + n * 2048 + k * 1024); } } } while (0)
#define PG8_MMA(ai, bj, At, Bt) do { __builtin_amdgcn_s_setprio(1); _Pragma("unroll") for (int m = 0; m < 4; ++m) _Pragma("unroll") for (int n = 0; n < 2; ++n) { \
        if constexpr (FP8) acc[ai][bj][m][n] = __builtin_amdgcn_mfma_scale_f32_16x16x128_f8f6f4(Bt##8[n], At##8[m], acc[ai][bj][m][n], 0, 0, 0, 0x7f7f7f7f, 0, 0x7f7f7f7f); \
        else { _Pragma("unroll") for (int k = 0; k < 2; ++k) acc[ai][bj][m][n] = __builtin_amdgcn_mfma_f32_16x16x32_bf16(Bt[n][k], At[m][k], acc[ai][bj][m][n], 0, 0, 0); } } \
        if constexpr (FP8) asm volatile("" : "+v"(acc[ai][bj][0][0]), "+v"(acc[ai][bj][0][1]), "+v"(acc[ai][bj][1][0]), "+v"(acc[ai][bj][1][1]), "+v"(acc[ai][bj][2][0]), "+v"(acc[ai][bj][2][1]), "+v"(acc[ai][bj][3][0]), "+v"(acc[ai][bj][3][1])); \
        __builtin_amdgcn_s_setprio(0); } while (0)
#define PG8_WAIT_V(n) asm volatile("s_waitcnt vmcnt(" #n ")" ::: "memory")
#define PG8_WAIT_L(n) asm volatile("s_waitcnt lgkmcnt(" #n ")" ::: "memory")
#define PG8_BAR __builtin_amdgcn_s_barrier()
#define PG8_SCHED __builtin_amdgcn_sched_barrier(0)
#define PG8_PIN do { if constexpr (FP8) __builtin_amdgcn_sched_barrier(0); } while (0)
    Unit cur, nxt; int ui = 0;
    if (!S.next(0, cur)) return;
    f32x4 acc[2][2][4][2];
#pragma unroll
    for (int a = 0; a < 2; ++a)
#pragma unroll
        for (int b = 0; b < 2; ++b)
#pragma unroll
            for (int m = 0; m < 4; ++m)
#pragma unroll
                for (int n = 0; n < 2; ++n) acc[a][b][m][n] = (f32x4){0.f, 0.f, 0.f, 0.f};
    bf16x8 At[4][2], B0[2][2], B1[2][2]; v8i At8[4], B08[2], B18[2];
    const char* cA = cur.a; const char* cB = cur.b;
    PG8_STAGE(PG8_SB(0, 0), cB, voffB); PG8_STAGE(PG8_SB(0, 1), cB + hstepB, voffB); PG8_STAGE(PG8_SA(0, 0), cA, voffA); PG8_STAGE(PG8_SA(0, 1), cA + hstepA, voffA);
    if (wr == 1) PG8_BAR;
    PG8_WAIT_V(2); PG8_BAR;
    PG8_STAGE(PG8_SB(1, 0), cB + kstep, voffB); PG8_STAGE(PG8_SA(1, 0), cA + kstep, voffA); PG8_STAGE(PG8_SB(1, 1), cB + hstepB + kstep, voffB);
    PG8_WAIT_V(6); PG8_BAR;
    for (;;) {
        const bool has_next = S.next(ui + 1, nxt);
        const char* nA = has_next ? nxt.a : cA; const char* nB = has_next ? nxt.b : cB;
        const int nt = VARNT ? cur.nt : nt_c;
        for (int t = 0; t < nt; t += 2) {
            const bool last = (t == nt - 2);
            const char* a1 = cA + (size_t)(t + 1) * kstep;
            const char* a2 = last ? nA : cA + (size_t)(t + 2) * kstep; const char* b2 = last ? nB : cB + (size_t)(t + 2) * kstep;
            const char* a3 = a2 + kstep; const char* b3 = b2 + kstep;
            PG8_LDB(B0, 0, 0); PG8_LDB(B1, 0, 1); PG8_SCHED; PG8_LDA(At, 0, 0); PG8_STAGE(PG8_SA(1, 1), a1 + hstepA, voffA);
            PG8_WAIT_V(8); PG8_WAIT_L(0); PG8_BAR; PG8_PIN; PG8_MMA(0, 0, At, B0); PG8_MMA(0, 1, At, B1); PG8_PIN; PG8_BAR; PG8_SCHED;
            PG8_LDA(At, 0, 1); PG8_STAGE(PG8_SB(0, 0), b2, voffB); PG8_STAGE(PG8_SB(0, 1), b2 + hstepB, voffB); PG8_STAGE(PG8_SA(0, 0), a2, voffA);
            PG8_WAIT_V(8); PG8_WAIT_L(0); PG8_BAR; PG8_PIN; PG8_MMA(1, 0, At, B0); PG8_MMA(1, 1, At, B1); PG8_PIN; PG8_BAR; PG8_SCHED;
            PG8_LDB(B0, 1, 0); PG8_LDB(B1, 1, 1); PG8_SCHED; PG8_LDA(At, 1, 0); PG8_STAGE(PG8_SA(0, 1), a2 + hstepA, voffA);
            PG8_WAIT_V(8); PG8_WAIT_L(0); PG8_BAR; PG8_PIN; PG8_MMA(0, 0, At, B0); PG8_MMA(0, 1, At, B1); PG8_PIN; PG8_BAR; PG8_SCHED;
            PG8_LDA(At, 1, 1); PG8_STAGE(PG8_SB(1, 0), b3, voffB); PG8_STAGE(PG8_SB(1, 1), b3 + hstepB, voffB); PG8_STAGE(PG8_SA(1, 0), a3, voffA);
            PG8_WAIT_V(8); PG8_WAIT_L(0); PG8_BAR; PG8_PIN; PG8_MMA(1, 0, At, B0); PG8_MMA(1, 1, At, B1); PG8_PIN; PG8_BAR; PG8_SCHED;
        }
        if constexpr (ALIGN_EPI) { if (wr == 0) PG8_BAR; }
        { const int l2 = lane_id(); E(acc, cur, wr, wc, l2 & 15, l2 >> 4); }
        if (!has_next) break;
        if (!E.keep(cur)) {
#pragma unroll
            for (int a = 0; a < 2; ++a)
#pragma unroll
                for (int b = 0; b < 2; ++b)
#pragma unroll
                    for (int m = 0; m < 4; ++m)
#pragma unroll
                        for (int n = 0; n < 2; ++n) acc[a][b][m][n] = (f32x4){0.f, 0.f, 0.f, 0.f};
        }
        cur = nxt; cA = nA; cB = nB; ++ui;
        if constexpr (ALIGN_EPI) { if (wr == 1) PG8_BAR; }
    }
    PG8_WAIT_V(0);
    if constexpr (!ALIGN_EPI) { if (wr == 0) PG8_BAR; }
    PG8_BAR;
#undef PG8_SA
#undef PG8_SB
#undef PG8_STAGE
#undef PG8_LDA
#undef PG8_LDB
#undef PG8_MMA
#undef PG8_CAT
#undef PG8_WAIT_V
#undef PG8_WAIT_L
#undef PG8_BAR
#undef PG8_SCHED
#undef PG8_PIN
}

typedef f32x4 Acc[2][2][4][2];
__device__ __forceinline__ u32x4 pack8(const f32x4 v0, const f32x4 v1) { u32x4 w; w.x = cvt_pk_bf16(v0[0], v0[1]); w.y = cvt_pk_bf16(v0[2], v0[3]); w.z = cvt_pk_bf16(v1[0], v1[1]); w.w = cvt_pk_bf16(v1[2], v1[3]); return w; }
__device__ __forceinline__ void unpack8(const u32x4 w, f32x4& v0, f32x4& v1) { v0 = (f32x4){bf_lo(w.x), bf_hi(w.x), bf_lo(w.y), bf_hi(w.y)}; v1 = (f32x4){bf_lo(w.z), bf_hi(w.z), bf_lo(w.w), bf_hi(w.w)}; }
__device__ __forceinline__ float sumsq4(const f32x4 v) { return (v[0] * v[0] + v[1] * v[1]) + (v[2] * v[2] + v[3] * v[3]); }

struct EpiProj {
    static constexpr bool PERM = true;
    bf16_t* PS; bf16_t* GT; float* rsq_q; float* rsq_kv; float lsc;
    const LAS float* rsl;
    __device__ __forceinline__ bool keep(const Unit&) const { return false; }
    __device__ __forceinline__ void operator()(Acc& acc, const Unit& u, int wr, int wc, int fr, int fq) const {
        const int row0 = u.pm * BM + wr * 64 + fr; const int rloc = u.aux * 256 + wr * 64 + fr;
        if (u.pn >= 9) {
            const int t = u.pn - 9; const int wave_c = wr * 4 + 2 * (t & 1) + (wc >> 1), lane_c = fr + 16 * (2 * (wc & 1) + (fq >> 1));
            char* gbase = (char*)GT + gate_unit_off(u.pm, t >> 2, 0) + (size_t)wave_c * 16384 + ((t >> 1) & 1) * 1024 + lane_c * 16 + (fq & 1) * 8;
#pragma unroll
            for (int ai = 0; ai < 2; ++ai)
#pragma unroll
                for (int m = 0; m < 4; ++m) { char* gp = gbase + (ai * 4 + m) * 2048;
                    f32x4 s0 = acc[ai][0][m][0], s1 = acc[ai][0][m][1], s2 = acc[ai][1][m][0], s3 = acc[ai][1][m][1];
                    const float ls2 = -lsc * LOG2E * rsl[rloc + ai * HALF + m * 16];
                    f32x4 e0 = s0 * ls2, e1 = s1 * ls2, e2 = s2 * ls2, e3 = s3 * ls2;
#pragma unroll
                    for (int j = 0; j < 4; ++j) { e0[j] = __builtin_amdgcn_exp2f(e0[j]); e1[j] = __builtin_amdgcn_exp2f(e1[j]); e2[j] = __builtin_amdgcn_exp2f(e2[j]); e3[j] = __builtin_amdgcn_exp2f(e3[j]); }
                    const f32x4 d0 = e0 + 1.0f, d1 = e1 + 1.0f, d2 = e2 + 1.0f, d3 = e3 + 1.0f;
                    f32x4 r0, r1, r2;
#pragma unroll
                    for (int j = 0; j < 4; ++j) { r0[j] = __builtin_amdgcn_rcpf(d0[j]); r1[j] = __builtin_amdgcn_rcpf(d1[j]); r2[j] = __builtin_amdgcn_rcpf(d2[j]); s3[j] = __builtin_amdgcn_rcpf(d3[j]); }
                    s0 = d1 * r0; s1 = d2 * r1; s2 = d3 * r2;
                    __builtin_nontemporal_store((u32x2){cvt_pk_bf16(s0[0], s0[1]), cvt_pk_bf16(s0[2], s0[3])}, (u32x2*)(gp)); __builtin_nontemporal_store((u32x2){cvt_pk_bf16(s1[0], s1[1]), cvt_pk_bf16(s1[2], s1[3])}, (u32x2*)(gp + (1 << 17)));
                    __builtin_nontemporal_store((u32x2){cvt_pk_bf16(s2[0], s2[1]), cvt_pk_bf16(s2[2], s2[3])}, (u32x2*)(gp + (2 << 17))); __builtin_nontemporal_store((u32x2){cvt_pk_bf16(s3[0], s3[1]), cvt_pk_bf16(s3[2], s3[3])}, (u32x2*)(gp + (3 << 17))); }
            return;
        }
        const float qs = (u.pn == 0 || u.pn == 3) ? 0.125f * LOG2E : 1.0f;
        const int col0 = u.pn * BM + wc * 32 + 8 * fq;
#pragma unroll
        for (int ai = 0; ai < 2; ++ai)
#pragma unroll
            for (int m = 0; m < 4; ++m) { const int row = row0 + ai * HALF + m * 16; bf16_t* rowp = PS + (size_t)row * NPS + col0; float ss0 = 0.f, ss1 = 0.f; const float rx = rsl[rloc + ai * HALF + m * 16];
#pragma unroll
                for (int bj = 0; bj < 2; ++bj) { f32x4 v0 = acc[ai][bj][m][0] * rx, v1 = acc[ai][bj][m][1] * rx;
                    const float s = sumsq4(v0) + sumsq4(v1); if (bj == 0) ss0 = s; else ss1 = s; v0 = v0 * qs; v1 = v1 * qs;
                    *(u32x4*)(rowp + bj * HALF) = pack8(v0, v1); }
                if (u.pn == 7 || u.pn == 8) { float s = (u.pn == 7) ? (ss0 + ss1) : ss0; s += __shfl_xor(s, 16); s += __shfl_xor(s, 32);
                    if (fq == 0) (u.pn == 7 ? rsq_q : rsq_kv)[row * 4 + wc] = s; } }
    }
};
struct EpiDup {
    static constexpr bool PERM = true;
    bf16_t* QD; bf16_t* KD; bf16_t* VD; const float* rsq_q; const float* rsq_kv; const float2* tab; float eps;
    __device__ __forceinline__ bool keep(const Unit&) const { return false; }
    __device__ __forceinline__ void operator()(Acc& acc, const Unit& u, int wr, int wc, int fr, int fq) const {
        const int row0 = u.pm * BM + wr * 64 + fr;
        if (u.pn < 2) {
#pragma unroll
            for (int ai = 0; ai < 2; ++ai)
#pragma unroll
                for (int m = 0; m < 4; ++m) { const int row = row0 + ai * HALF + m * 16; const int pos = row & (SEQ - 1);
                    const f32x4 pq = *(const f32x4*)(rsq_q + row * 4); const float rq = __builtin_amdgcn_rsqf(fmaf((pq[0] + pq[1]) + (pq[2] + pq[3]), 1.0f / 256.0f, eps)) * (0.10206207261596577f * LOG2E);
#pragma unroll
                    for (int bj = 0; bj < 2; ++bj) { const int cb = u.pn * 8 + bj * 4 + wc;
                        if (cb < 12) { f32x4 v0 = acc[ai][bj][m][0] * rq, v1 = acc[ai][bj][m][1] * rq;
                            if (cb % 3 == 2) {
                                const float2* tp = tab + pos * 16 + 4 * fq;
#pragma unroll
                                for (int j = 0; j < 4; ++j) { const float2 cs = tp[j]; const float a = v0[j], b = v1[j]; v0[j] = a * cs.x - b * cs.y; v1[j] = b * cs.x + a * cs.y; }
                            }
                            *(u32x4*)(QD + (size_t)row * 384 + cb * 32 + 8 * fq) = pack8(v0, v1); } }
                    if (m & 1) asm volatile("" ::: "memory"); }
        } else {
#pragma unroll
            for (int ai = 0; ai < 2; ++ai)
#pragma unroll
                for (int m = 0; m < 4; ++m) { const int row = row0 + ai * HALF + m * 16;
                    const f32x4 pk = *(const f32x4*)(rsq_kv + row * 4); const float rkv = __builtin_amdgcn_rsqf(fmaf((pk[0] + pk[1]) + (pk[2] + pk[3]), 1.0f / 128.0f, eps));
#pragma unroll
                    for (int bj = 0; bj < 2; ++bj) { const int cbk = (u.pn - 2) * 8 + bj * 4 + wc, h = cbk >> 2, part = cbk & 3;
                        const f32x4 v0 = acc[ai][bj][m][0] * rkv, v1 = acc[ai][bj][m][1] * rkv;
                        bf16_t* dst = (part < 2) ? (KD + (size_t)row * 384 + h * 96 + part * 32 + 8 * fq) : (VD + (size_t)row * 256 + h * 64 + (part - 2) * 32 + 8 * fq);
                        *(u32x4*)dst = pack8(v0, v1); }
                    if (m & 1) asm volatile("" ::: "memory"); }
        }
    }
};
struct EpiGate {
    static constexpr bool PERM = true;
    bf16_t* GT;
    __device__ __forceinline__ bool keep(const Unit& u) const { return u.aux < 3; }
    __device__ __forceinline__ void operator()(Acc& acc, const Unit& u, int wr, int wc, int fr, int fq) const {
        const int row0 = u.pm * BM + wr * 64 + fr, n = u.aux; const int col0 = n * 1024 + u.pn * BM + wc * 32 + 8 * fq;
        bf16_t* gp0 = GT + (size_t)row0 * NGT + col0;
        u32x4 G[2][4][2];
#pragma unroll
        for (int ai = 0; ai < 2; ++ai)
#pragma unroll
            for (int m = 0; m < 4; ++m)
#pragma unroll
                for (int bj = 0; bj < 2; ++bj) G[ai][m][bj] = *(const u32x4*)(gp0 + (size_t)(ai * HALF + m * 16) * NGT + bj * HALF);
#pragma unroll
        for (int ai = 0; ai < 2; ++ai)
#pragma unroll
            for (int m = 0; m < 4; ++m)
#pragma unroll
                for (int bj = 0; bj < 2; ++bj) { f32x4 g0, g1; unpack8(G[ai][m][bj], g0, g1);
                    if (n < 3) { acc[ai][bj][m][0] = acc[ai][bj][m][0] * g0; acc[ai][bj][m][1] = acc[ai][bj][m][1] * g1; }
                    else { *(u32x4*)(gp0 + (size_t)(ai * HALF + m * 16) * NGT + bj * HALF) = pack8(acc[ai][bj][m][0] * g0, acc[ai][bj][m][1] * g1); } }
    }
};
struct EpiOutSq {
    static constexpr bool PERM = true;
    bf16_t* O;
    __device__ __forceinline__ bool keep(const Unit&) const { return false; }
    __device__ __forceinline__ void operator()(Acc& acc, const Unit& u, int wr, int wc, int fr, int fq) const {
        const int row0 = u.pm * BM + wr * 64 + fr; const int col0 = u.pn * BM + wc * 32 + 8 * fq;
#pragma unroll
        for (int ai = 0; ai < 2; ++ai)
#pragma unroll
            for (int m = 0; m < 4; ++m) { const int row = row0 + ai * HALF + m * 16; bf16_t* rowp = O + (size_t)row * DM + col0;
#pragma unroll
                for (int bj = 0; bj < 2; ++bj) *(u32x4*)(rowp + bj * HALF) = pack8(acc[ai][bj][m][0], acc[ai][bj][m][1]); }
    }
};
struct EpiSwiglu {
    static constexpr bool PERM = true;
    bf16_t* ACT; const LAS float* rsl;
    __device__ __forceinline__ bool keep(const Unit&) const { return false; }
    __device__ __forceinline__ void operator()(Acc& acc, const Unit& u, int wr, int wc, int fr, int fq) const {
        const int row0 = u.pm * BM + wr * 64 + fr; const int col0 = u.pn * HALF + wc * 32 + 8 * fq; const int rloc = u.aux * 256 + wr * 64 + fr;
#pragma unroll
        for (int ai = 0; ai < 2; ++ai)
#pragma unroll
            for (int m = 0; m < 4; ++m) { const float rx = rsl[rloc + ai * HALF + m * 16];
                f32x4 g0 = acc[ai][0][m][0] * rx, g1 = acc[ai][0][m][1] * rx; const f32x4 u0 = acc[ai][1][m][0] * rx, u1 = acc[ai][1][m][1] * rx;
                f32x4 t0 = g0 * (-LOG2E), t1 = g1 * (-LOG2E);
#pragma unroll
                for (int j = 0; j < 4; ++j) { t0[j] = __builtin_amdgcn_exp2f(t0[j]); t1[j] = __builtin_amdgcn_exp2f(t1[j]); }
                t0 = t0 + 1.0f; t1 = t1 + 1.0f;
#pragma unroll
                for (int j = 0; j < 4; ++j) { t0[j] = __builtin_amdgcn_rcpf(t0[j]); t1[j] = __builtin_amdgcn_rcpf(t1[j]); }
                g0 = (g0 * u0) * t0; g1 = (g1 * u1) * t1;
                *(u32x4*)(ACT + (size_t)(row0 + ai * HALF + m * 16) * DFF + col0) = pack8(g0, g1); }
    }
};

__device__ __forceinline__ void gemm_g3(LAS unsigned char* lds, const int wid, const SchedBranch& S, const char* GTf, bf16_t* MG) {
    const int lane = lane_id(), tid = wid * 64 + lane, wr = wid >> 2, wc = wid & 3, fr = lane & 15, fq = lane >> 4;
    constexpr int lda = NPS, ldb = 256;
    unsigned voffA[2], voffB[2], voffG[2];
#pragma unroll
    for (int i = 0; i < 2; ++i) { int R, C; stage_rc(tid * 16 + i * 8192, R, C); const int Rb = (R & ~31) + perm32(R & 31);
        voffA[i] = (unsigned)(R * lda + C) * 2u; voffB[i] = (unsigned)(Rb * ldb + C) * 2u; voffG[i] = (unsigned)(wid * 16384 + i * 1024 + lane * 16); }
    const size_t kstep = (size_t)(BK * 2);
    const size_t hstepA = (size_t)HALF * lda * 2, hstepB = (size_t)HALF * ldb * 2;
    const unsigned ldsw = (unsigned)wid * 1024u;
    const unsigned basel = (unsigned)lds_byte(fr, fq * 8); const unsigned aoffs = (unsigned)wr * 8192u, boffs = (unsigned)wc * 4096u;
    const unsigned ownl = ldsw + (unsigned)lane * 16u;
#define G3_SA(b, h) (((b) * 2 + (h)) * HTB)
#define G3_SB(b, h) ((4 + (b) * 2 + (h)) * HTB)
#define G3_STAGE(bufoff, gbase, voff) do { _Pragma("unroll") for (int _i = 0; _i < 2; ++_i) \
        __builtin_amdgcn_global_load_lds((const unsigned*)((const char*)(gbase) + (voff)[_i]), (LAS unsigned*)(lds + (bufoff) + ldsw + _i * 8192), 16, 0, 0); } while (0)
#define G3_STAGE_NT(bufoff, gbase, voff) do { _Pragma("unroll") for (int _i = 0; _i < 2; ++_i) \
        __builtin_amdgcn_global_load_lds((const unsigned*)((const char*)(gbase) + (voff)[_i]), (LAS unsigned*)(lds + (bufoff) + ldsw + _i * 8192), 16, 0, 2); } while (0)
#define G3_LDA(dst, b, h) do { unsigned ad_ = basel + (aoffs + (unsigned)G3_SA(b, h)); asm volatile("" : "+v"(ad_)); _Pragma("unroll") for (int m = 0; m < 4; ++m) { \
        _Pragma("unroll") for (int k = 0; k < 2; ++k) dst[m][k] = *(const LAS bf16x8*)(lds + ad_ + m * 2048 + k * 1024); } } while (0)
#define G3_LDB(dst, b, h) do { unsigned ad_ = basel + (boffs + (unsigned)G3_SB(b, h)); asm volatile("" : "+v"(ad_)); _Pragma("unroll") for (int n = 0; n < 2; ++n) { \
        _Pragma("unroll") for (int k = 0; k < 2; ++k) dst[n][k] = *(const LAS bf16x8*)(lds + ad_ + n * 2048 + k * 1024); } } while (0)
#define G3_MMA(ai, bj, At, Bt) do { __builtin_amdgcn_s_setprio(1); _Pragma("unroll") for (int m = 0; m < 4; ++m) _Pragma("unroll") for (int n = 0; n < 2; ++n) { \
        _Pragma("unroll") for (int k = 0; k < 2; ++k) acc[ai][bj][m][n] = __builtin_amdgcn_mfma_f32_16x16x32_bf16(Bt[n][k], At[m][k], acc[ai][bj][m][n], 0, 0, 0); } \
        __builtin_amdgcn_s_setprio(0); } while (0)
#define G3_WAIT_V(n) asm volatile("s_waitcnt vmcnt(" #n ")" ::: "memory")
#define G3_WAIT_L(n) asm volatile("s_waitcnt lgkmcnt(" #n ")" ::: "memory")
#define G3_BAR __builtin_amdgcn_s_barrier()
#define G3_SCHED __builtin_amdgcn_sched_barrier(0)
#define G3_GRD(dst, soff) do { _Pragma("unroll") for (int _i = 0; _i < 2; ++_i) dst[_i] = *(const LAS u32x4*)(lds + (soff) + ownl + _i * 8192); } while (0)
#define G3_GAPPLY(src, gv, s_) do { _Pragma("unroll") for (int _i = 0; _i < 2; ++_i) { f32x4 g0_, g1_; unpack8(src[_i], g0_, g1_); \
        if (nbr < 3) { acc[gv][_i][s_][0] = acc[gv][_i][s_][0] * g0_; acc[gv][_i][s_][1] = acc[gv][_i][s_][1] * g1_; } \
        else { *(u32x4*)(mrow + (size_t)((gv) * HALF + (s_) * 16) * DM + _i * HALF) = pack8(acc[gv][_i][s_][0] * g0_, acc[gv][_i][s_][1] * g1_); \
               acc[gv][_i][s_][0] = (f32x4){0.f, 0.f, 0.f, 0.f}; acc[gv][_i][s_][1] = (f32x4){0.f, 0.f, 0.f, 0.f}; } } } while (0)
    Unit cur, nxt; int ui = 0;
    if (!S.next(0, cur)) return;
    f32x4 acc[2][2][4][2];
#pragma unroll
    for (int a = 0; a < 2; ++a)
#pragma unroll
        for (int b = 0; b < 2; ++b)
#pragma unroll
            for (int m = 0; m < 4; ++m)
#pragma unroll
                for (int n = 0; n < 2; ++n) acc[a][b][m][n] = (f32x4){0.f, 0.f, 0.f, 0.f};
    bf16x8 At[4][2], B0[2][2], B1[2][2]; u32x4 gA[2], gB0[2], gB1[2];
    const char* cA = cur.a; const char* cB = cur.b;
    G3_STAGE(G3_SB(0, 0), cB, voffB); G3_STAGE(G3_SB(0, 1), cB + hstepB, voffB); G3_STAGE(G3_SA(0, 0), cA, voffA); G3_STAGE(G3_SA(0, 1), cA + hstepA, voffA);
    if (wr == 1) G3_BAR;
    G3_WAIT_V(2); G3_BAR;
    G3_STAGE(G3_SB(1, 0), cB + kstep, voffB); G3_STAGE(G3_SA(1, 0), cA + kstep, voffA); G3_STAGE(G3_SB(1, 1), cB + hstepB + kstep, voffB);
    G3_WAIT_V(6); G3_BAR;
    for (;;) {
        const bool has_next = S.next(ui + 1, nxt);
        const char* nA = has_next ? nxt.a : cA; const char* nB = has_next ? nxt.b : cB;
        const char* cG = GTf + gate_unit_off(cur.pm, cur.pn, cur.aux); const int nbr = cur.aux;
        bf16_t* mrow = MG + (size_t)(cur.pm * BM + wr * 64 + fr) * DM + cur.pn * BM + wc * 32 + 8 * fq;
#define G3_GP(gv, s_) (cG + (size_t)(((gv) * 8 + (s_) * 2) * 1024))
        { const char* a1 = cA + kstep; const char* a2 = cA + 2 * kstep; const char* b2 = cB + 2 * kstep; const char* a3 = a2 + kstep; const char* b3 = b2 + kstep;
            G3_LDB(B0, 0, 0); G3_LDB(B1, 0, 1); G3_SCHED; G3_LDA(At, 0, 0); G3_STAGE(G3_SA(1, 1), a1 + hstepA, voffA);
            G3_WAIT_V(8); G3_WAIT_L(0); G3_BAR; G3_MMA(0, 0, At, B0); G3_MMA(0, 1, At, B1); G3_BAR; G3_SCHED;
            G3_LDA(At, 0, 1); G3_STAGE(G3_SB(0, 0), b2, voffB); G3_STAGE(G3_SB(0, 1), b2 + hstepB, voffB); G3_STAGE(G3_SA(0, 0), a2, voffA);
            G3_WAIT_V(8); G3_WAIT_L(0); G3_BAR; G3_MMA(1, 0, At, B0); G3_MMA(1, 1, At, B1); G3_BAR; G3_SCHED;
            G3_LDB(B0, 1, 0); G3_LDB(B1, 1, 1); G3_SCHED; G3_LDA(At, 1, 0); G3_STAGE(G3_SA(0, 1), a2 + hstepA, voffA);
            G3_WAIT_V(8); G3_WAIT_L(0); G3_BAR; G3_MMA(0, 0, At, B0); G3_MMA(0, 1, At, B1); G3_BAR; G3_SCHED;
            G3_LDA(At, 1, 1); G3_STAGE(G3_SB(1, 0), b3, voffB); G3_STAGE(G3_SB(1, 1), b3 + hstepB, voffB); G3_STAGE(G3_SA(1, 0), a3, voffA);
            G3_WAIT_V(8); G3_WAIT_L(0); G3_BAR; G3_MMA(1, 0, At, B0); G3_MMA(1, 1, At, B1); G3_BAR; G3_SCHED; }
        { const char* a1 = cA + 3 * kstep;
            G3_LDB(B0, 0, 0); G3_LDB(B1, 0, 1); G3_SCHED; G3_LDA(At, 0, 0); G3_STAGE(G3_SA(1, 1), a1 + hstepA, voffA);
            G3_WAIT_V(8); G3_WAIT_L(0); G3_BAR; G3_MMA(0, 0, At, B0); G3_MMA(0, 1, At, B1); G3_BAR; G3_SCHED;
            G3_LDA(At, 0, 1); G3_STAGE_NT(G3_SB(0, 0), G3_GP(0, 2), voffG); G3_STAGE_NT(G3_SB(0, 1), G3_GP(0, 3), voffG); G3_STAGE_NT(G3_SA(0, 0), G3_GP(0, 0), voffG);
            G3_WAIT_V(8); G3_WAIT_L(0); G3_BAR; G3_MMA(1, 0, At, B0); G3_MMA(1, 1, At, B1); G3_BAR; G3_SCHED;
            G3_LDB(B0, 1, 0); G3_LDB(B1, 1, 1); G3_SCHED; G3_LDA(At, 1, 0); G3_STAGE_NT(G3_SA(0, 1), G3_GP(0, 1), voffG);
            G3_WAIT_V(8); G3_WAIT_L(0); G3_BAR; G3_MMA(0, 0, At, B0); G3_MMA(0, 1, At, B1); G3_BAR; G3_SCHED;
            G3_LDA(At, 1, 1); G3_STAGE_NT(G3_SB(1, 0), G3_GP(1, 2), voffG); G3_STAGE_NT(G3_SB(1, 1), G3_GP(1, 3), voffG); G3_STAGE_NT(G3_SA(1, 0), G3_GP(1, 0), voffG);
            G3_WAIT_V(8); G3_WAIT_L(0); G3_BAR; G3_MMA(1, 0, At, B0); G3_MMA(1, 1, At, B1); G3_BAR; G3_SCHED; }
        {   G3_GRD(gB0, G3_SB(0, 0)); G3_GRD(gB1, G3_SB(0, 1)); G3_GRD(gA, G3_SA(0, 0)); G3_STAGE_NT(G3_SA(1, 1), G3_GP(1, 1), voffG);
            G3_WAIT_V(8); G3_WAIT_L(0); G3_BAR; G3_GAPPLY(gB0, 0, 2); G3_GAPPLY(gB1, 0, 3); G3_GAPPLY(gA, 0, 0); G3_BAR; G3_SCHED;
            G3_GRD(gA, G3_SA(0, 1)); G3_STAGE(G3_SB(0, 0), nB, voffB); G3_STAGE(G3_SB(0, 1), nB + hstepB, voffB); G3_STAGE(G3_SA(0, 0), nA, voffA);
            G3_WAIT_V(8); G3_WAIT_L(0); G3_BAR; G3_GAPPLY(gA, 0, 1); G3_BAR; G3_SCHED;
            G3_GRD(gB0, G3_SB(1, 0)); G3_GRD(gB1, G3_SB(1, 1)); G3_GRD(gA, G3_SA(1, 0)); G3_STAGE(G3_SA(0, 1), nA + hstepA, voffA);
            G3_WAIT_V(8); G3_WAIT_L(0); G3_BAR; G3_GAPPLY(gB0, 1, 2); G3_GAPPLY(gB1, 1, 3); G3_GAPPLY(gA, 1, 0); G3_BAR; G3_SCHED;
            G3_GRD(gA, G3_SA(1, 1)); G3_STAGE(G3_SB(1, 0), nB + kstep, voffB); G3_STAGE(G3_SB(1, 1), nB + hstepB + kstep, voffB); G3_STAGE(G3_SA(1, 0), nA + kstep, voffA);
            G3_WAIT_V(8); G3_WAIT_L(0); G3_BAR; G3_GAPPLY(gA, 1, 1); G3_BAR; G3_SCHED; }
#undef G3_GP
        if (!has_next) break;
        cur = nxt; cA = nA; cB = nB; ++ui;
    }
    G3_WAIT_V(0);
    if (wr == 0) G3_BAR;
    G3_BAR;
#undef G3_SA
#undef G3_SB
#undef G3_STAGE
#undef G3_STAGE_NT
#undef G3_LDA
#undef G3_LDB
#undef G3_MMA
#undef G3_WAIT_V
#undef G3_WAIT_L
#undef G3_BAR
#undef G3_SCHED
#undef G3_GRD
#undef G3_GAPPLY
}
}

namespace att {
constexpr int NW = 8, QBLK = 32, KVBLK = 64;
constexpr int L_V = 0, L_K = 16384, L_WS = 16384 + 32768, L_TAB = L_WS + 2048, L_BYTES = L_TAB + 4096;
constexpr int TSH_B = 128, TSH_A = 48;
constexpr float THR2 = 8.0f;
constexpr float NEG = -1e30f, MINIT = -1e4f;
#define SBAR() __builtin_amdgcn_sched_barrier(0)
__device__ __forceinline__ int crow(int r, int hi) { return (r & 3) + 8 * (r >> 2) + 4 * hi; }
template <int DQK> __device__ __forceinline__ int k_off(int row, int c) {
    if (DQK == 64) return row * 128 + ((c ^ ((row >> 1) & 7)) << 4);
    else return row * 256 + ((c ^ (row & 15)) << 4);
}
__device__ __forceinline__ int v_st(int k, int c) { return (c >> 5) * 4096 + k * 64 + (c & 31) * 2; }
__device__ __forceinline__ int v_rd_base(int lane) { return (((lane >> 4) & 1) << 5) | ((lane & 3) << 3) | ((4 * (lane >> 5) + ((lane & 15) >> 2)) << 6); }
constexpr int v_rd_off(int d0, int ks, int half) { return d0 * 4096 + ks * 1024 + half * 512; }
template <int OFF> __device__ __forceinline__ s16x4 tr_read(int vb) { s16x4 r; asm volatile("ds_read_b64_tr_b16 %0, %1 offset:%2" : "=&v"(r) : "v"(vb), "i"(OFF) : "memory"); return r; }
template <int D0> __device__ __forceinline__ void pv_one(f32x16& od, int vb, bf16x8 pa0, bf16x8 pa1, bf16x8 pa2, bf16x8 pa3) {
    const s16x4 l0 = tr_read<v_rd_off(D0, 0, 0)>(vb), h0 = tr_read<v_rd_off(D0, 0, 1)>(vb), l1 = tr_read<v_rd_off(D0, 1, 0)>(vb), h1 = tr_read<v_rd_off(D0, 1, 1)>(vb);
    const s16x4 l2 = tr_read<v_rd_off(D0, 2, 0)>(vb), h2 = tr_read<v_rd_off(D0, 2, 1)>(vb), l3 = tr_read<v_rd_off(D0, 3, 0)>(vb), h3 = tr_read<v_rd_off(D0, 3, 1)>(vb);
    asm volatile("s_waitcnt lgkmcnt(0)" ::: "memory"); SBAR();
#define PK(L, H) (bf16x8){L[0], L[1], L[2], L[3], H[0], H[1], H[2], H[3]}
    od = __builtin_amdgcn_mfma_f32_32x32x16_bf16(pa0, PK(l0, h0), od, 0, 0, 0);
    od = __builtin_amdgcn_mfma_f32_32x32x16_bf16(pa1, PK(l1, h1), od, 0, 0, 0);
    od = __builtin_amdgcn_mfma_f32_32x32x16_bf16(pa2, PK(l2, h2), od, 0, 0, 0);
    od = __builtin_amdgcn_mfma_f32_32x32x16_bf16(pa3, PK(l3, h3), od, 0, 0, 0);
#undef PK
}
__device__ __forceinline__ void pv_all(f32x16* o, int vb, bf16x8 pa0, bf16x8 pa1, bf16x8 pa2, bf16x8 pa3) { pv_one<0>(o[0], vb, pa0, pa1, pa2, pa3); pv_one<1>(o[1], vb, pa0, pa1, pa2, pa3); }

typedef short v4i16_t __attribute__((ext_vector_type(4)));
__device__ __forceinline__ s16x4 vtr(const LAS char* p) { return __builtin_bit_cast(s16x4, __builtin_amdgcn_ds_read_tr16_b64_v4i16((LAS v4i16_t*)p)); }
template <int DQK, bool DO_QK, bool DO_PV>
__device__ __forceinline__ void mstep(f32x16& p0, f32x16& p1, f32x16* o, const LAS char* Ks, const LAS char* Vs  , const bf16x8* qr, const float nm  ,
                                      const bf16x8 pa0, const bf16x8 pa1, const bf16x8 pa2, const bf16x8 pa3, const int r32, const int hi) {
    bf16x8 kf[DQK / 8]; s16x4 vl[8], vh[8];
    if (DO_QK) {
#pragma unroll
        for (int d0 = 0; d0 < DQK / 16; ++d0) { const int c = 2 * d0 + hi; kf[2 * d0] = *(const LAS bf16x8*)(Ks + k_off<DQK>(r32, c)); kf[2 * d0 + 1] = *(const LAS bf16x8*)(Ks + k_off<DQK>(32 + r32, c)); } }
    if (DO_PV) {
#pragma unroll
        for (int i = 0; i < 8; ++i) { vl[i] = vtr(Vs + (i >> 2) * 4096 + (i & 3) * 1024); vh[i] = vtr(Vs + (i >> 2) * 4096 + (i & 3) * 1024 + 512); } }
    __builtin_amdgcn_sched_barrier(0);
    if (DO_QK) {
#pragma unroll
        for (int r = 0; r < 16; ++r) { p0[r] = nm; p1[r] = nm; }
#pragma unroll
        for (int d0 = 0; d0 < DQK / 16; ++d0) { p0 = __builtin_amdgcn_mfma_f32_32x32x16_bf16(kf[2 * d0], qr[d0], p0, 0, 0, 0); p1 = __builtin_amdgcn_mfma_f32_32x32x16_bf16(kf[2 * d0 + 1], qr[d0], p1, 0, 0, 0); } }
    if (DO_PV) {
#define VF(i) (bf16x8){vl[i][0], vl[i][1], vl[i][2], vl[i][3], vh[i][0], vh[i][1], vh[i][2], vh[i][3]}
#pragma unroll
        for (int d0 = 0; d0 < 2; ++d0) { o[d0] = __builtin_amdgcn_mfma_f32_32x32x16_bf16(pa0, VF(d0 * 4 + 0), o[d0], 0, 0, 0); o[d0] = __builtin_amdgcn_mfma_f32_32x32x16_bf16(pa1, VF(d0 * 4 + 1), o[d0], 0, 0, 0);
            o[d0] = __builtin_amdgcn_mfma_f32_32x32x16_bf16(pa2, VF(d0 * 4 + 2), o[d0], 0, 0, 0); o[d0] = __builtin_amdgcn_mfma_f32_32x32x16_bf16(pa3, VF(d0 * 4 + 3), o[d0], 0, 0, 0); }
#undef VF
    }
    if (DO_QK) { asm volatile("" : "+v"(p0), "+v"(p1)); }
    if (DO_PV) { asm volatile("" : "+v"(o[0]), "+v"(o[1])); }
    __builtin_amdgcn_sched_barrier(0);
}
struct MP { int ib; int colb; int R; int rs; int rstart; int jlo, jhi; };
template <int MODE> __device__ __forceinline__ void softmax_tile(f32x16& p0, f32x16& p1, float& mhat, float& alpha, float& l_reg, const int j, const MP& mp, const LAS float* tab,
                                                                 bf16x8& pa0, bf16x8& pa1, bf16x8& pa2, bf16x8& pa3) {
    if (MODE == 1) {
        const int base = mp.ib + 64 * j;
#pragma unroll
        for (int r = 0; r < 16; ++r) { const int i0 = base + (r & 3) + 8 * (r >> 2), i1 = i0 + 32;
            p0[r] += tab[i0 + TSH_B]; p1[r] += tab[i1 + TSH_B]; }
    } else if (MODE == 2) {
        const int KR = mp.rstart + j; const int dr = KR - mp.R + 7;
        const int ibase = dr * 31 + 15 + mp.ib;
#pragma unroll
        for (int r = 0; r < 16; ++r) { const int kc0 = (r & 3) + 8 * (r >> 2), kc1 = kc0 + 32;
            const bool ok0 = (unsigned)(mp.colb + kc0) < 16u, ok1 = (unsigned)(mp.colb + kc1) < 16u;
            const float b0 = tab[ibase + kc0 + TSH_A], b1 = tab[ibase + kc1 + TSH_A];
            p0[r] = (p0[r] + b0) + (ok0 ? 0.f : NEG); p1[r] = (p1[r] + b1) + (ok1 ? 0.f : NEG); }
    }
    float pmax = fmaxf(fmaxf(p0[0], p0[1]), p1[0]);
#pragma unroll
    for (int r = 2; r < 16; r += 2) pmax = fmaxf(fmaxf(pmax, p0[r]), p0[r + 1]);
#pragma unroll
    for (int r = 1; r < 15; r += 2) pmax = fmaxf(fmaxf(pmax, p1[r]), p1[r + 1]);
    pmax = fmaxf(pmax, p1[15]);
    { auto rr = __builtin_amdgcn_permlane32_swap(__float_as_uint(pmax), __float_as_uint(pmax), false, false);
      pmax = fmaxf(__uint_as_float(rr[0]), __uint_as_float(rr[1])); }
    if (__builtin_expect(__all(pmax <= THR2), 1)) { alpha = 1.f; }
    else { const float dl = fmaxf(pmax, 0.f); mhat += dl; alpha = __builtin_amdgcn_exp2f(-dl);
#pragma unroll
        for (int r = 0; r < 16; ++r) { p0[r] -= dl; p1[r] -= dl; } }
#pragma unroll
    for (int r = 0; r < 16; ++r) { p0[r] = __builtin_amdgcn_exp2f(p0[r]); p1[r] = __builtin_amdgcn_exp2f(p1[r]); }
    float ps = 0;
#pragma unroll
    for (int r = 0; r < 16; ++r) ps += p0[r];
#pragma unroll
    for (int r = 0; r < 16; ++r) ps += p1[r];
    { auto rr = __builtin_amdgcn_permlane32_swap(__float_as_uint(ps), __float_as_uint(ps), false, false);
      ps = __uint_as_float(rr[0]) + __uint_as_float(rr[1]); }
    l_reg = l_reg * alpha + ps;
#define PK8(P, B) __builtin_bit_cast(bf16x8, (u32x4){cvt_pk_bf16(P[B], P[B + 1]), cvt_pk_bf16(P[B + 2], P[B + 3]), cvt_pk_bf16(P[B + 4], P[B + 5]), cvt_pk_bf16(P[B + 6], P[B + 7])})
    pa0 = PK8(p0, 0); pa1 = PK8(p0, 8); pa2 = PK8(p1, 0); pa3 = PK8(p1, 8);
#undef PK8
}
template <int DQK> __device__ __forceinline__ void qkt(f32x16& p0, f32x16& p1, const LAS char* Ks, const bf16x8* qr, const f32x16& negm, int r32, int hi) {
    p0 = negm; p1 = negm;
#pragma unroll
    for (int d0 = 0; d0 < DQK / 16; ++d0) { const int c = 2 * d0 + hi;
        const bf16x8 b0 = *(const LAS bf16x8*)(Ks + k_off<DQK>(r32, c));
        const bf16x8 b1 = *(const LAS bf16x8*)(Ks + k_off<DQK>(32 + r32, c));
        p0 = __builtin_amdgcn_mfma_f32_32x32x16_bf16(b0, qr[d0], p0, 0, 0, 0);
        p1 = __builtin_amdgcn_mfma_f32_32x32x16_bf16(b1, qr[d0], p1, 0, 0, 0); }
}
template <int DQK, int MODE>
__device__ __forceinline__ void attn_unit(const bf16_t* __restrict__ Qb, const int ldq, const bf16_t* __restrict__ Kh, const int ldk, const bf16_t* __restrict__ Vh, const int ldv,
                                          bf16_t* Ob, const int ldo, const int kstart, const int NT, const float m_init, const float l_init, const MP mp, LAS char* lds, const int wid) {
    const int lane = lane_id(), tid = wid * 64 + lane, r32 = lane & 31, hi = lane >> 5; const int hb = wid >> 2;
    constexpr int KBUF = 16384, VBUF = 8192;
    LAS char* V_lds = lds + L_V; LAS char* K_lds = lds + L_K;
    LAS float* ws = (LAS float*)(lds + L_WS) + wid * 64; LAS float* li_l = ws; LAS float* al_l = ws + 32;
    const LAS float* tab = (const LAS float*)(lds + L_TAB);
    float mhat = m_init, l_reg = l_init; f32x16 o[2] = {}; bf16x8 qr[DQK / 16];
    const bf16_t* Qw = Qb + (size_t)(wid * QBLK + r32) * ldq + hi * 8;
#pragma unroll
    for (int d0 = 0; d0 < DQK / 16; ++d0) qr[d0] = *reinterpret_cast<const bf16x8*>(Qw + d0 * 16);
    const int sr = tid >> 3, sc = tid & 7, sr2 = (tid & 255) >> 2, sc2 = 8 + (tid & 3);
    const int kst0 = k_off<DQK>(sr, sc), kst2 = (DQK == 96) ? k_off<DQK>(sr2, sc2) : 0, vst0 = v_st(sr, sc * 8);
    const int vrb = v_rd_base(lane);
    const bf16_t* Kg = Kh + (size_t)(kstart + sr) * ldk + sc * 8; const bf16_t* Kg2 = Kh + (size_t)(kstart + sr2) * ldk + sc2 * 8; const bf16_t* Vg = Vh + (size_t)(kstart + sr) * ldv + sc * 8;
    bf16x8 skA, sk2A, svA, skB, sk2B, svB;
#define KLOAD(K_, K2_, t) do { if ((t) < NT) { K_ = *reinterpret_cast<const bf16x8*>(Kg + (size_t)(t) * KVBLK * ldk); if (DQK == 96) K2_ = *reinterpret_cast<const bf16x8*>(Kg2 + (size_t)(t) * KVBLK * ldk); } } while (0)
#define VLOAD(V_, t) do { if ((t) < NT) V_ = *reinterpret_cast<const bf16x8*>(Vg + (size_t)(t) * KVBLK * ldv); } while (0)
#define KWRITE(K_, K2_, t) do { if ((t) < NT) { *(LAS bf16x8*)(K_lds + ((t) & 1) * KBUF + kst0) = K_; if (DQK == 96) *(LAS bf16x8*)(K_lds + ((t) & 1) * KBUF + kst2) = K2_; } } while (0)
#define VWRITE(V_, t) do { if ((t) < NT) *(LAS bf16x8*)(V_lds + ((t) & 1) * VBUF + vst0) = V_; } while (0)
#define STEP_BAR() do { asm volatile("s_waitcnt lgkmcnt(0)" ::: "memory"); __builtin_amdgcn_s_barrier(); asm volatile("" ::: "memory"); } while (0)
#define RESC(a) do { if (__any((a) < 1.f)) { if (hi == 0) al_l[r32] = (a); asm volatile("s_waitcnt lgkmcnt(0)" ::: "memory"); \
    _Pragma("unroll") for (int d = 0; d < 2; ++d) _Pragma("unroll") for (int r = 0; r < 16; ++r) o[d][r] *= al_l[crow(r, hi)]; } } while (0)
    const int jlo = __builtin_amdgcn_readfirstlane(mp.jlo), jhi = __builtin_amdgcn_readfirstlane(mp.jhi);
#define ACT(t) (MODE == 0 || ((t) >= jlo && (t) < jhi))
    f32x16 p0, p1; float al; bf16x8 pa0, pa1, pa2, pa3;
    KLOAD(skA, sk2A, 0); KWRITE(skA, sk2A, 0);
    if (hb) { KLOAD(skB, sk2B, 1); VLOAD(svB, 0); KWRITE(skB, sk2B, 1); VWRITE(svB, 0); }
    KLOAD(skA, sk2A, 1 + hb); VLOAD(svA, hb); KLOAD(skB, sk2B, 2 + hb); VLOAD(svB, 1 + hb);
    STEP_BAR();
    if (hb) STEP_BAR();
#define MSTEP(t) do { const bool q_ = ACT(t), v_ = (t) > 0 && ACT((t) - 1); const LAS char* Ks_ = K_lds + ((t) & 1) * KBUF; const LAS char* Vs_ = V_lds + (((t) - 1) & 1) * VBUF + vrb; \
        if (q_ && v_) mstep<DQK, true, true>(p0, p1, o, Ks_, Vs_, qr, -mhat, pa0, pa1, pa2, pa3, r32, hi); \
        else if (q_) mstep<DQK, true, false>(p0, p1, o, Ks_, Vs_, qr, -mhat, pa0, pa1, pa2, pa3, r32, hi); \
        else if (v_) mstep<DQK, false, true>(p0, p1, o, Ks_, Vs_, qr, -mhat, pa0, pa1, pa2, pa3, r32, hi); STEP_BAR(); } while (0)
#define VSTEP(t, K_, K2_, V_) do { if (ACT(t)) { softmax_tile<MODE>(p0, p1, mhat, al, l_reg, (t), mp, tab, pa0, pa1, pa2, pa3); RESC(al); } \
        KWRITE(K_, K2_, (t) + 1 + hb); VWRITE(V_, (t) + hb); KLOAD(K_, K2_, (t) + 3 + hb); VLOAD(V_, (t) + 2 + hb); STEP_BAR(); } while (0)
    if (hb) __builtin_amdgcn_s_setprio(1);
    for (int t = 0; t < NT; t += 2) {
        MSTEP(t);     VSTEP(t, skA, sk2A, svA);
        MSTEP(t + 1); VSTEP(t + 1, skB, sk2B, svB);
    }
    if (ACT(NT - 1)) mstep<DQK, false, true>(p0, p1, o, K_lds, V_lds + ((NT - 1) & 1) * VBUF + vrb, qr, -mhat, pa0, pa1, pa2, pa3, r32, hi);
    STEP_BAR();
    if (!hb) STEP_BAR();
    __builtin_amdgcn_s_setprio(0);
#undef MSTEP
#undef VSTEP
#undef ACT
    if (hi == 0) li_l[r32] = l_reg; asm volatile("s_waitcnt lgkmcnt(0)" ::: "memory");
    float rli[16];
#pragma unroll
    for (int r = 0; r < 16; ++r) rli[r] = __builtin_amdgcn_rcpf(li_l[crow(r, hi)]);
    bf16_t* Ow = Ob + (size_t)(wid * QBLK) * ldo;
    {
        LAS bf16_t* stg = (LAS bf16_t*)(K_lds + wid * 4096);
#pragma unroll
        for (int r = 0; r < 16; ++r) { const int orow = crow(r, hi);
#pragma unroll
            for (int d0 = 0; d0 < 2; ++d0) stg[orow * 64 + d0 * 32 + r32] = (bf16_t)f2bf(o[d0][r] * rli[r]); }
        asm volatile("s_waitcnt lgkmcnt(0)" ::: "memory");
#pragma unroll
        for (int i = 0; i < 4; ++i) { const int row = i * 8 + (lane >> 3), ch = lane & 7; const u32x4 v = *(const LAS u32x4*)(stg + row * 64 + ch * 8); *(u32x4*)(Ow + (size_t)row * ldo + ch * 8) = v; }
    }
    __syncthreads();
#undef KLOAD
#undef VLOAD
#undef KWRITE
#undef VWRITE
#undef STEP_BAR
#undef RESC
}
#undef SBAR
}


#define XB_TMO      128
#define XB_XCNT(j)  (256  + 64 * (j))
#define XB_XSUB(j)  (1280 + 64 * (j))
#define XB_XGEN(j)  (2304 + 64 * (j))
#define XB_TOP      3328
#define XB_TOPGEN   3392
#define XCD_BAR_WORDS 3456
#define XB_SPIN_CAP (1u << 20)
__device__ __forceinline__ unsigned xb_ld(unsigned* p)              { return __hip_atomic_load(p, __ATOMIC_RELAXED, __HIP_MEMORY_SCOPE_AGENT); }
__device__ __forceinline__ unsigned xb_add(unsigned* p, unsigned v) { return __hip_atomic_fetch_add(p, v, __ATOMIC_RELAXED, __HIP_MEMORY_SCOPE_AGENT); }
__device__ __forceinline__ unsigned xb_xcc_id() { return (unsigned)__builtin_amdgcn_s_getreg((3 << 11) | 20) & 0xFu; }
#define XB_SPIN(cond, bar) do { unsigned _sp = 0; while (cond) { __builtin_amdgcn_s_sleep(1); \
    if ((++_sp & 255u) == 0u) { if (xb_ld(&(bar)[XB_TMO])) break; if (_sp > XB_SPIN_CAP) { atomicAdd(&(bar)[XB_TMO], 1u); break; } } } } while (0)
__device__ __forceinline__ void xcd_barrier_complete(unsigned* bar, unsigned x, unsigned G, unsigned& nloc, unsigned& nx) {
    unsigned sum, cnt, mine, sp = 0u;
    for (;;) {
        sum = 0u; cnt = 0u; mine = 0u;
#pragma unroll
        for (unsigned j = 0; j < 16; ++j) { const unsigned c = xb_ld(&bar[XB_XCNT(j)]); sum += c; cnt += (c > 0u) ? 1u : 0u; mine = (j == x) ? c : mine; }
        if (sum == G) break;
        __builtin_amdgcn_s_sleep(1);
        if ((++sp & 255u) == 0u) { if (xb_ld(&bar[XB_TMO])) break; if (sp > XB_SPIN_CAP) { atomicAdd(&bar[XB_TMO], 1u); break; } }
    }
    nloc = mine > 0u ? mine : 1u; nx = cnt > 0u ? cnt : 1u;
}
__device__ __forceinline__ void xcd_barrier(unsigned* bar, volatile LAS unsigned* st, const bool leader_thread, const unsigned G) {
    asm volatile("s_waitcnt vmcnt(0)" ::: "memory");
    __syncthreads();
    if (leader_thread) {
        const unsigned x = xb_xcc_id();
        __builtin_amdgcn_s_waitcnt(0);
        unsigned nloc = st[0], nx = st[1];
        if (nloc == 0u) { xcd_barrier_complete(bar, x, G, nloc, nx); st[0] = nloc; st[1] = nx; }
        const unsigned old = xb_add(&bar[XB_XSUB(x)], 1u);
        const unsigned gen = old / nloc;
        if (old + 1u == (gen + 1u) * nloc) {
            __builtin_amdgcn_fence(__ATOMIC_RELEASE, "agent");
            asm volatile("s_waitcnt vmcnt(0)" ::: "memory");
            asm volatile("buffer_inv sc1" ::: "memory");
            const unsigned og = xb_add(&bar[XB_TOP], 1u);
            const unsigned tg = og / nx;
            if (og + 1u == (tg + 1u) * nx) xb_add(&bar[XB_TOPGEN], 1u);
            else XB_SPIN(xb_ld(&bar[XB_TOPGEN]) == tg, bar);
            asm volatile("s_waitcnt vmcnt(0)" ::: "memory");
            xb_add(&bar[XB_XGEN(x)], 1u);
            asm volatile("s_waitcnt vmcnt(0)" ::: "memory");
        } else {
            asm volatile("buffer_inv sc1" ::: "memory");
            XB_SPIN(xb_ld(&bar[XB_XGEN(x)]) == gen, bar);
            asm volatile("s_waitcnt vmcnt(0)" ::: "memory");
        }
    }
    __syncthreads();
}

constexpr int NWAVES = 8;
constexpr int LDS_BYTES = 147456;
constexpr int RING_BYTES = 131072, MISC_OFF = RING_BYTES + 1024;
#define KAS __attribute__((address_space(4)))
struct Args { const float* in[19]; float* out; unsigned char* ws; int ph_lo, ph_hi; };
struct Frame {
    LAS unsigned char* lds; char* ldsg;
    int wave, vcu, G, gw, NGW;
    KAS const unsigned long long* ka; float* out; unsigned char* ws;
    __device__ __forceinline__ const float* inp(int i) const { return (const float*)(GAS const float*)ka[i]; }
};
__device__ __forceinline__ void frame_refresh(Frame& F) {
    { int w = F.wave; asm volatile("" : "+s"(w)); F.wave = w; }
    KAS const unsigned long long* ka = (KAS const unsigned long long*)__builtin_amdgcn_kernarg_segment_ptr(); asm volatile("" : "+s"(ka));
    F.ka = ka; F.out = (float*)(GAS float*)ka[19]; F.ws = (unsigned char*)(GAS unsigned char*)ka[20];
    F.gw = F.vcu * NWAVES + F.wave;
}
constexpr int I_X = 0, I_WIN = 1, I_RPB = 2, I_SINK = 3, I_T5 = 4, I_CQN = 5, I_CKN = 6, I_DQN = 7, I_DKVN = 8, I_DWQ = 9, I_DWKV = 10, I_WBR = 11, I_WOUT = 12,
              I_LPM = 13, I_LPOM = 14, I_LPF = 15, I_LPOF = 16, I_WGU = 17, I_WDN = 18;

template <class Fn, bool FP8OUT>
__device__ __forceinline__ void tr_items_t(Frame& Fr, const Fn f, const float scale, const int Kd, const int Nd, void* WT, const int ldd, int& itbase) {
    const int nblk = Nd / 64, nitems = (Kd / 64) * nblk, lane = lane_id();
    int first = (Fr.gw - (itbase % Fr.NGW) + Fr.NGW) % Fr.NGW;
    for (int it = first; it < nitems; it += Fr.NGW) {
        const int kb = it / nblk, nb = it % nblk, k0 = 64 * kb, n = 64 * nb + lane;
        const float* src; int stride; const float* ksc;
        const bool valid = f.src(k0, n, src, stride, ksc);
        float v[64];
#pragma unroll
        for (int j = 0; j < 64; ++j) v[j] = 0.f;
        if (valid) {
#pragma unroll
            for (int j = 0; j < 64; ++j) v[j] = __builtin_nontemporal_load(src + (size_t)j * stride);
            if (ksc) {
#pragma unroll
                for (int j = 0; j < 64; ++j) v[j] *= ksc[j]; }
        }
        if (FP8OUT) {
            u32x4* dst = (u32x4*)((unsigned char*)WT + (size_t)n * ldd + k0);
#pragma unroll
            for (int g = 0; g < 4; ++g) { int w[4];
#pragma unroll
                for (int q = 0; q < 4; ++q) { int x = 0; x = __builtin_amdgcn_cvt_pk_fp8_f32(v[16 * g + 4 * q] * scale, v[16 * g + 4 * q + 1] * scale, x, false); x = __builtin_amdgcn_cvt_pk_fp8_f32(v[16 * g + 4 * q + 2] * scale, v[16 * g + 4 * q + 3] * scale, x, true); w[q] = x; }
                dst[g] = (u32x4){(unsigned)w[0], (unsigned)w[1], (unsigned)w[2], (unsigned)w[3]}; }
        } else {
            u32x4* dst = (u32x4*)((bf16_t*)WT + (size_t)n * ldd + k0);
#pragma unroll
            for (int g = 0; g < 8; ++g) { u32x4 o; o.x = cvt_pk_bf16(v[8 * g], v[8 * g + 1]); o.y = cvt_pk_bf16(v[8 * g + 2], v[8 * g + 3]); o.z = cvt_pk_bf16(v[8 * g + 4], v[8 * g + 5]); o.w = cvt_pk_bf16(v[8 * g + 6], v[8 * g + 7]); dst[g] = o; }
        }
    }
    itbase += nitems;
}
template <class Fn> __device__ __forceinline__ void tr_items(Frame& Fr, const Fn f, const int Kd, const int Nd, bf16_t* WT, const int ldd, int& itbase) { tr_items_t<Fn, false>(Fr, f, 1.0f, Kd, Nd, WT, ldd, itbase); }
template <class Fn> __device__ __forceinline__ void tr_items8(Frame& Fr, const Fn f, const float scale, const int Kd, const int Nd, unsigned char* WT, const int ldd, int& itbase) { tr_items_t<Fn, true>(Fr, f, scale, Kd, Nd, WT, ldd, itbase); }
__device__ __forceinline__ int win_col(int n) { if (n < 2208) return n; if (n < NPS) return -1; const int t = (n - NPS) >> 8, c = (n - NPS) & 255;
    const int g = 2 * (c >> 7) + ((c >> 2) & 1), d = 64 * t + 16 * ((c >> 5) & 3) + 4 * ((c >> 3) & 3) + (c & 3); return 2208 + g * 1024 + d; }
struct FnWin { const float* W; int noff; const float* gk;
    __device__ __forceinline__ bool src(int k0, int n, const float*& p, int& st, const float*& ks) const { const int sc = win_col(n + noff); p = W + (size_t)k0 * NIN + (sc < 0 ? 0 : sc); st = NIN; ks = gk + k0; return sc >= 0; } };
struct FnDup { const float* Wq; const float* Wkv; const float* gq; const float* gkv;
    __device__ __forceinline__ bool src(int k0, int n, const float*& p, int& st, const float*& ks) const {
        if (n < 384) { const int h = n / 96, w = n % 96; int sc; if (w < 64) sc = 96 * h + w; else { const int q = w - 64; sc = 96 * h + 64 + 4 * (q >> 3) + (q & 3) + 16 * ((q >> 2) & 1); }
            const bool ok = k0 < 256; p = Wq + (size_t)(ok ? k0 : 0) * 384 + sc; st = 384; ks = gq + (ok ? k0 : 0); return ok; }
        const bool ok = (n >= 512) && (k0 >= 256); p = Wkv + (size_t)(ok ? k0 - 256 : 0) * 512 + (ok ? n - 512 : 0); st = 512; ks = gkv + (ok ? k0 - 256 : 0); return ok; } };
struct FnBr { const float* W; __device__ __forceinline__ bool src(int k0, int n, const float*& p, int& st, const float*& ks) const { const int nb = n >> 10, d = n & 1023; p = W + ((size_t)nb * 256 + k0) * DM + d; st = DM; ks = nullptr; return true; } };
struct FnPlain { const float* W; int N, off; __device__ __forceinline__ bool src(int k0, int n, const float*& p, int& st, const float*& ks) const { p = W + (size_t)k0 * N + n + off; st = N; ks = nullptr; return true; } };
struct FnGu { const float* W; const float* gk;
    __device__ __forceinline__ bool src(int k0, int n, const float*& p, int& st, const float*& ks) const { const int pn = n >> 8, w = n & 255; const int sc = (w < 128) ? (128 * pn + w) : (DFF + 128 * pn + (w - 128));
        p = W + (size_t)k0 * NGU + sc; st = NGU; ks = gk + k0; return true; } };
__device__ __forceinline__ void convert_wa(Frame& F, const int l) {
    int itbase = 0;
    tr_items(F, FnWin{F.inp(I_WIN) + (size_t)l * DM * NIN, 0, F.inp(I_LPM) + l * DM}, DM, NPS, (bf16_t*)(F.ws + WS_WIN), DM, itbase);
    tr_items8(F, FnWin{F.inp(I_WIN) + (size_t)l * DM * NIN, NPS, F.inp(I_LPM) + l * DM}, 32.0f, DM, NGT, (unsigned char*)(F.ws + WS_WG8), DM, itbase);
    tr_items(F, FnDup{F.inp(I_DWQ) + (size_t)l * 256 * 384, F.inp(I_DWKV) + (size_t)l * 128 * 512, F.inp(I_DQN) + l * 256, F.inp(I_DKVN) + l * 128}, 384, 1024, (bf16_t*)(F.ws + WS_WDUP), 384, itbase);
    tr_items(F, FnBr{F.inp(I_WBR) + (size_t)l * 4 * 256 * DM}, 256, 4096, (bf16_t*)(F.ws + WS_WBR), 256, itbase);
    tr_items(F, FnPlain{F.inp(I_WOUT) + (size_t)l * DM * DM, DM, 0}, DM, DM, (bf16_t*)(F.ws + WS_WOUT), DM, itbase);
}
__device__ __forceinline__ void convert_wb(Frame& F, const int l) {
    int itbase = 0;
    tr_items(F, FnGu{F.inp(I_WGU) + (size_t)l * DM * NGU, F.inp(I_LPF) + l * DM}, DM, NGU, (bf16_t*)(F.ws + WS_WGU), DM, itbase);
    tr_items(F, FnPlain{F.inp(I_WDN) + (size_t)l * DFF * DM, DM, 0}, DFF, DM, (bf16_t*)(F.ws + WS_WDN), DFF, itbase);
}
constexpr int RB = 4;
__device__ __forceinline__ void store_x_row(const int lane, const f32x4 (&v)[4], bf16_t* xrow, unsigned char* x8row) {
#pragma unroll
    for (int j = 0; j < 4; ++j) { const f32x4 y = v[j];
        if (xrow) ((unsigned long long*)xrow + lane)[64 * j] = (unsigned long long)cvt_pk_bf16(y[0], y[1]) | ((unsigned long long)cvt_pk_bf16(y[2], y[3]) << 32);
        if (x8row) { int x = 0; x = __builtin_amdgcn_cvt_pk_fp8_f32(y[0], y[1], x, false); x = __builtin_amdgcn_cvt_pk_fp8_f32(y[2], y[3], x, true); ((int*)x8row)[lane + 64 * j] = x; } }
}
__device__ __forceinline__ void cast_rows(Frame& F, const float* x, bf16_t* XB, unsigned char* X8, float* rsx) {
    const int lane = lane_id();
    for (int m0 = F.gw; m0 < M; m0 += RB * F.NGW) {
        f32x4 v[RB][4]; float ss[RB];
#pragma unroll
        for (int r = 0; r < RB; ++r) { const int m = m0 + r * F.NGW;
#pragma unroll
            for (int j = 0; j < 4; ++j) v[r][j] = __builtin_nontemporal_load((const f32x4*)(x + (size_t)m * DM) + lane + 64 * j); }
#pragma unroll
        for (int r = 0; r < RB; ++r) { float s = 0.f;
#pragma unroll
            for (int j = 0; j < 4; ++j) s += pg8::sumsq4(v[r][j]);
            ss[r] = s; }
#pragma unroll
        for (int o = 1; o < 64; o <<= 1) {
#pragma unroll
            for (int r = 0; r < RB; ++r) ss[r] += __shfl_xor(ss[r], o); }
#pragma unroll
        for (int r = 0; r < RB; ++r) { const int m = m0 + r * F.NGW; store_x_row(lane, v[r], XB + (size_t)m * DM, X8 + (size_t)m * DM);
            if (lane == 0) rsx[m] = __builtin_amdgcn_rsqf(ss[r] * (1.0f / DM) + EPS); }
    }
}
template <bool XIN_BF, bool XOUT_BF>
__device__ __forceinline__ void resid_rows(Frame& F, const void* xin_, void* xout_, const bf16_t* Y, const float* gpost, unsigned char* X8, float* rsx) {
    const int lane = lane_id(); f32x4 gp[4];
#pragma unroll
    for (int j = 0; j < 4; ++j) gp[j] = *((const f32x4*)gpost + lane + 64 * j);
    for (int m0 = F.gw; m0 < M; m0 += RB * F.NGW) {
        f32x4 v[RB][4]; u32x2 yw[RB][4]; float ss[RB];
#pragma unroll
        for (int r = 0; r < RB; ++r) { const int m = m0 + r * F.NGW;
#pragma unroll
            for (int j = 0; j < 4; ++j) yw[r][j] = __builtin_nontemporal_load((const u32x2*)(Y + (size_t)m * DM) + lane + 64 * j); }
#pragma unroll
        for (int r = 0; r < RB; ++r) { const int m = m0 + r * F.NGW;
#pragma unroll
            for (int j = 0; j < 4; ++j) {
                if (XIN_BF) { const u32x2 xw = __builtin_nontemporal_load((const u32x2*)((const bf16_t*)xin_ + (size_t)m * DM) + lane + 64 * j); v[r][j] = (f32x4){bf_lo(xw.x), bf_hi(xw.x), bf_lo(xw.y), bf_hi(xw.y)}; }
                else v[r][j] = __builtin_nontemporal_load((const f32x4*)((const float*)xin_ + (size_t)m * DM) + lane + 64 * j); } }
#pragma unroll
        for (int r = 0; r < RB; ++r) { float s = 0.f;
#pragma unroll
            for (int j = 0; j < 4; ++j) { const float a = bf_lo(yw[r][j].x), b = bf_hi(yw[r][j].x), c = bf_lo(yw[r][j].y), d = bf_hi(yw[r][j].y); s += (a * a + b * b) + (c * c + d * d); }
            ss[r] = s; }
#pragma unroll
        for (int o = 1; o < 64; o <<= 1) {
#pragma unroll
            for (int r = 0; r < RB; ++r) ss[r] += __shfl_xor(ss[r], o); }
#pragma unroll
        for (int r = 0; r < RB; ++r) { const int m = m0 + r * F.NGW; const float rstd = __builtin_amdgcn_rsqf(ss[r] * (1.0f / DM) + EPS); float s2 = 0.f;
#pragma unroll
            for (int j = 0; j < 4; ++j) { const f32x4 yv = (f32x4){bf_lo(yw[r][j].x), bf_hi(yw[r][j].x), bf_lo(yw[r][j].y), bf_hi(yw[r][j].y)};
                v[r][j] = v[r][j] + yv * rstd * gp[j];
                if (XOUT_BF) *((u32x2*)((bf16_t*)xout_ + (size_t)m * DM) + lane + 64 * j) = (u32x2){cvt_pk_bf16(v[r][j][0], v[r][j][1]), cvt_pk_bf16(v[r][j][2], v[r][j][3])};
                else __builtin_nontemporal_store(v[r][j], (f32x4*)((float*)xout_ + (size_t)m * DM) + lane + 64 * j);
                s2 += pg8::sumsq4(v[r][j]); }
            ss[r] = s2;
            if (X8) store_x_row(lane, v[r], nullptr, X8 + (size_t)m * DM); }
        if (rsx) {
#pragma unroll
            for (int o = 1; o < 64; o <<= 1) {
#pragma unroll
                for (int r = 0; r < RB; ++r) ss[r] += __shfl_xor(ss[r], o); }
#pragma unroll
            for (int r = 0; r < RB; ++r) if (lane == 0) rsx[m0 + r * F.NGW] = __builtin_amdgcn_rsqf(ss[r] * (1.0f / DM) + EPS);
        }
    }
}

__device__ __forceinline__ float* rsx_ptr(Frame& F, int kind) { return (float*)(F.ws + WS_RSX) + (size_t)kind * M; }
__device__ __forceinline__ void phase_p0(Frame& F) {
    { const int lane = lane_id(); float2* tab = (float2*)(F.ws + WS_TAB);
      for (int e = F.gw * 64 + lane; e < SEQ * 16; e += F.NGW * 64) { const int pos = e >> 4, i = e & 15;
          const float invf = 1.0f / powf(10000.0f, (float)i * 0.0625f); const float ang = (float)pos * invf; tab[e] = make_float2(cosf(ang), sinf(ang)); } }
    convert_wa(F, 0);
    cast_rows(F, F.inp(I_X), (bf16_t*)(F.ws + WS_HS), (unsigned char*)F.out, rsx_ptr(F, 0));
}
__device__ __forceinline__ float* rsq_ptr(Frame& F, int l, int kind) { return (float*)(F.ws + WS_RSQ) + ((size_t)l * 2 + kind) * M * 4; }

__device__ __forceinline__ void phase_g1(Frame& F, const int l) {
    pg8::SchedTiles S{l == 0 ? (const bf16_t*)(F.ws + WS_HS) : (const bf16_t*)F.out + (size_t)M * DM, (const bf16_t*)(F.ws + WS_WIN), DM, DM, M / 256, NPS / 256, F.G, cur_bid()};
    const int nb = ((M / 256) * (NPS / 256) + F.G - 1) / F.G, ng = ((M / 256) * (NGT / 256) + F.G - 1) / F.G + 1;
    pg8::SchedGateBal S2{(const bf16_t*)F.out, (const bf16_t*)(F.ws + WS_WG8), DM / 2, DM / 2, F.G, S.c, NPS / 256, nb};
    {
        const int tid = cur_tid(F.wave); pg8::fill_rsx_lds(F.lds, tid, S, rsx_ptr(F, 0), nb); pg8::fill_rsx_lds(F.lds, tid, S2, rsx_ptr(F, 0), ng); }
    {
        pg8::EpiProj E{(bf16_t*)(F.ws + WS_PS), (bf16_t*)(F.ws + WS_GT), rsq_ptr(F, l, 0), rsq_ptr(F, l, 1), 1.0f / 32.0f, (const LAS float*)(F.lds + pg8::RSX_LDS)};
        pg8::gemm_phase<pg8::EpiProj, pg8::SchedGateBal, true, DM / 2, DM / 2, DM / 2, true>(F.lds, F.wave, S2, E);
    }
    frame_refresh(F);
    {
        pg8::SchedTiles S1{l == 0 ? (const bf16_t*)(F.ws + WS_HS) : (const bf16_t*)F.out + (size_t)M * DM, (const bf16_t*)(F.ws + WS_WIN), DM, DM, M / 256, NPS / 256, F.G, cur_bid()};
        pg8::EpiProj E{(bf16_t*)(F.ws + WS_PS), (bf16_t*)(F.ws + WS_GT), rsq_ptr(F, l, 0), rsq_ptr(F, l, 1), 1.0f, (const LAS float*)(F.lds + pg8::RSX_LDS)};
        pg8::gemm_phase<pg8::EpiProj, pg8::SchedTiles, true, DM, DM, DM>(F.lds, F.wave, S1, E);
    }
}
__device__ __forceinline__ void phase_prep(Frame& F, const int l) {
    {
        pg8::SchedDup S{(const bf16_t*)(F.ws + WS_PS), (const bf16_t*)(F.ws + WS_WDUP), F.G, cur_bid()};
        pg8::EpiDup E{(bf16_t*)(F.ws + WS_QD), (bf16_t*)(F.ws + WS_KD), (bf16_t*)(F.ws + WS_VD), rsq_ptr(F, l, 0), rsq_ptr(F, l, 1), (const float2*)(F.ws + WS_TAB), __builtin_bit_cast(float, __builtin_amdgcn_readfirstlane(0x358637bd))};
        pg8::gemm_phase<pg8::EpiDup, pg8::SchedDup, false, 384, NPS, 384, false, true>(F.lds, F.wave, S, E);
    }
    frame_refresh(F);
    bf16_t* PS = (bf16_t*)(F.ws + WS_PS); bf16_t* KD = (bf16_t*)(F.ws + WS_KD); const float2* tab = (const float2*)(F.ws + WS_TAB);
    const int lane = lane_id(); const bool isc = lane < 48, act = lane < 52; const int L = act ? lane : 51;
    const int hh = L >> 3, c = isc ? (L & 7) : (L - 48), half = isc ? (c >> 2) : 0, cc = c & 3; const bool lo = cc < 2;
    const int coff = isc ? (C_CQ + 64 * hh + 8 * c) : (C_DKR + 8 * c);
    float g[8];
    { const float* gp = (hh < 4 ? F.inp(I_CQN) : F.inp(I_CKN)) + l * 64 + 8 * (isc ? c : 0);
#pragma unroll
      for (int j = 0; j < 8; ++j) g[j] = gp[j]; }
    const int kp0 = 16 * (c & 1) + 4 * (c >> 1);
    for (int m0 = F.gw; m0 < M; m0 += 2 * F.NGW) {
        u32x4 xw[2];
#pragma unroll
        for (int r = 0; r < 2; ++r) xw[r] = *(const u32x4*)(PS + (size_t)(m0 + r * F.NGW) * NPS + coff);
#pragma unroll
        for (int r = 0; r < 2; ++r) { const int m = m0 + r * F.NGW, t = m & (SEQ - 1); const int pos = isc ? (half ? (t & 63) : (t >> 6)) : t;
            const float2* tp = tab + pos * 16 + 8 * (cc & 1);
            float x[8] = {bf_lo(xw[r].x), bf_hi(xw[r].x), bf_lo(xw[r].y), bf_hi(xw[r].y), bf_lo(xw[r].z), bf_hi(xw[r].z), bf_lo(xw[r].w), bf_hi(xw[r].w)};
            float s = 0.f;
#pragma unroll
            for (int j = 0; j < 8; ++j) s += x[j] * x[j];
            s += __shfl_xor(s, 1); s += __shfl_xor(s, 2); s += __shfl_xor(s, 4);
            const float rstd = isc ? __builtin_amdgcn_rsqf(s * (1.0f / 64.0f) + EPS) * (hh < 4 ? 0.125f * LOG2E : 1.0f) : 1.0f;
            float o[8];
#pragma unroll
            for (int j = 0; j < 8; ++j) { const float y = isc ? x[j] * rstd * g[j] : x[j]; const float yp = __shfl_xor(y, 2); const float2 cs = tp[j];
                o[j] = lo ? (y * cs.x - yp * cs.y) : (y * cs.x + yp * cs.y); }
            u32x4 w; w.x = cvt_pk_bf16(o[0], o[1]); w.y = cvt_pk_bf16(o[2], o[3]); w.z = cvt_pk_bf16(o[4], o[5]); w.w = cvt_pk_bf16(o[6], o[7]);
            if (isc) *(u32x4*)(PS + (size_t)m * NPS + coff) = w;
            else if (act) {
#pragma unroll
                for (int h = 0; h < 4; ++h) { bf16_t* kd = KD + (size_t)m * 384 + 96 * h + 64 + kp0; *(u32x2*)kd = (u32x2){w.x, w.y}; *(u32x2*)(kd + 8) = (u32x2){w.z, w.w}; } }
        }
    }
}
__device__ __forceinline__ void phase_attn(Frame& F, const int l) {
    LAS char* lds = (LAS char*)F.lds; LAS float* tab = (LAS float*)(lds + att::L_TAB);
    for (int un = F.vcu; un < 256; un += F.G) {
        const int b = un >> 6, h = (un >> 4) & 3, qb = un & 15; const size_t rowb = (size_t)b * SEQ; const int q0 = qb * 256;
        { bf16_t* PS = (bf16_t*)(F.ws + WS_PS); const float* rpb = F.inp(I_RPB) + ((size_t)l * 4 + h) * 465;
          const int lane = lane_id(), wid = F.wave, tid = wid * 64 + lane, r32 = lane & 31, hi = lane >> 5;
          for (int e = tid; e < 1024; e += 512) { const int i = e - att::TSH_A; tab[e] = ((unsigned)i < 465u) ? rpb[i] * LOG2E : 0.f; }
          __syncthreads();
          const int R = 4 * qb + (wid >> 1), col = 32 * (wid & 1) + r32; const int rs = min(max(R - 4, 0), 56), cs = min(max(col - 8, 0), 48); const int rstart = min(max(4 * qb - 4, 0), 52);
          att::MP mp; mp.ib = 4 * hi - col; mp.colb = 4 * hi - cs; mp.R = R; mp.rs = rs; mp.rstart = rstart; mp.jlo = rs - rstart; mp.jhi = rs - rstart + 8;
          att::attn_unit<64, 2>(PS + (rowb + q0) * NPS + C_AQ + h * 64, NPS, PS + rowb * NPS + C_AK + h * 64, NPS, PS + rowb * NPS + C_AV + h * 64, NPS,
                                PS + (rowb + q0) * NPS + C_AQ + h * 64, NPS, rstart * 64, 12, 0.f, 0.f, mp, lds, F.wave); }
        { bf16_t* PS = (bf16_t*)(F.ws + WS_PS); const float* t5 = F.inp(I_T5);
          const int lane = lane_id(), wid = F.wave, tid = wid * 64 + lane, r32 = lane & 31, hi = lane >> 5;
          for (int e = tid; e < 1024; e += 512) { const int i = e - att::TSH_B; const int rel = i - 128, n = rel < 0 ? -rel : rel;
              const int lg = n >= 91 ? 15 : n >= 64 ? 14 : n >= 46 ? 13 : n >= 32 ? 12 : n >= 23 ? 11 : n >= 16 ? 10 : n >= 12 ? 9 : 8; const int bk = (rel > 0 ? 16 : 0) + (n < 8 ? n : lg);
              tab[e] = ((unsigned)i <= 256u) ? t5[bk * 4 + h] * LOG2E : att::NEG; }
          __syncthreads();
          const int kstart = max(0, q0 - 128), kend = min(SEQ, q0 + 384); const int t = q0 + 32 * wid + r32;
          att::MP mp; mp.ib = 128 - t + 4 * hi + kstart; mp.colb = 0; mp.R = 0; mp.rs = 0; mp.rstart = 0;
          { const int t0 = q0 + 32 * wid; mp.jlo = (max(kstart, t0 - 128) - kstart) >> 6; mp.jhi = ((min(kend - 1, t0 + 159) - kstart) >> 6) + 1; }
          const float sink2 = F.inp(I_SINK)[l * 4 + h] * LOG2E; const int hkv = h >> 1;
          att::attn_unit<64, 1>(PS + (rowb + q0) * NPS + C_BQ + h * 64, NPS, PS + rowb * NPS + C_BK + hkv * 64, NPS, PS + rowb * NPS + C_BV + hkv * 64, NPS,
                                PS + (rowb + q0) * NPS + C_BQ + h * 64, NPS, kstart, (kend - kstart) / 64, sink2, 1.0f, mp, lds, F.wave); }
        { bf16_t* PS = (bf16_t*)(F.ws + WS_PS); att::MP mp; mp.ib = 0; mp.colb = 0; mp.R = 0; mp.rs = 0; mp.rstart = 0; mp.jlo = 0; mp.jhi = 0; const int hkv = h >> 1;
          att::attn_unit<64, 0>(PS + (rowb + q0) * NPS + C_CQ + h * 64, NPS, PS + rowb * NPS + C_CK + hkv * 64, NPS, PS + rowb * NPS + C_CV + hkv * 64, NPS,
                                PS + (rowb + q0) * NPS + C_CQ + h * 64, NPS, 0, SEQ / 64, 0.f, 0.f, mp, lds, F.wave); }
        { bf16_t* PS = (bf16_t*)(F.ws + WS_PS); const bf16_t* QD = (const bf16_t*)(F.ws + WS_QD); const bf16_t* KD = (const bf16_t*)(F.ws + WS_KD); const bf16_t* VD = (const bf16_t*)(F.ws + WS_VD);
          att::MP mp; mp.ib = 0; mp.colb = 0; mp.R = 0; mp.rs = 0; mp.rstart = 0; mp.jlo = 0; mp.jhi = 0;
          att::attn_unit<96, 0>(QD + (rowb + q0) * 384 + h * 96, 384, KD + rowb * 384 + h * 96, 384, VD + rowb * 256 + h * 64, 256,
                                PS + (rowb + q0) * NPS + C_DCQ + h * 64, NPS, 0, SEQ / 64, 0.f, 0.f, mp, lds, F.wave); }
    }
}
__device__ __forceinline__ void phase_g3(Frame& F, const int l) {
    pg8::SchedBranch S{(const bf16_t*)(F.ws + WS_PS), (const bf16_t*)(F.ws + WS_WBR), F.G, cur_bid()};
    pg8::gemm_g3(F.lds, F.wave, S, (const char*)(F.ws + WS_GT), (bf16_t*)(F.ws + WS_HS));
}
__device__ __forceinline__ void phase_g4(Frame& F, const int l) {
    pg8::SchedTiles S{(const bf16_t*)(F.ws + WS_HS), (const bf16_t*)(F.ws + WS_WOUT), DM, DM, M / 256, 4, F.G, cur_bid()};
    pg8::EpiOutSq E{(bf16_t*)(F.ws + WS_MO)};
    pg8::gemm_phase<pg8::EpiOutSq, pg8::SchedTiles, false, DM, DM, DM>(F.lds, F.wave, S, E);
}
__device__ __forceinline__ void phase_n1(Frame& F, const int l) {
    convert_wb(F, l);
    const bf16_t* Y = (const bf16_t*)(F.ws + WS_MO); const float* gp = F.inp(I_LPOM) + l * DM;
    if (l == 0) resid_rows<false, true>(F, F.inp(I_X), F.ws + WS_XS, Y, gp, nullptr, rsx_ptr(F, 1));
    else resid_rows<true, true>(F, (const bf16_t*)F.out + (size_t)M * DM, F.ws + WS_XS, Y, gp, nullptr, rsx_ptr(F, 1));
}
__device__ __forceinline__ void phase_g5(Frame& F, const int l) {
    pg8::SchedTiles S{(const bf16_t*)(F.ws + WS_XS), (const bf16_t*)(F.ws + WS_WGU), DM, DM, M / 256, NGU / 256, F.G, cur_bid()};
    pg8::EpiSwiglu E{(bf16_t*)(F.ws + WS_ACT), (const LAS float*)(F.lds + pg8::RSX_LDS)};
    { pg8::fill_rsx_lds(F.lds, cur_tid(F.wave), S, rsx_ptr(F, 1), ((M / 256) * (NGU / 256) + F.G - 1) / F.G); }
    pg8::gemm_phase<pg8::EpiSwiglu, pg8::SchedTiles, true, DM, DM, DM>(F.lds, F.wave, S, E);
    if (l + 1 < DEPTH) { constexpr int nunits = (M / 256) * (NGU / 256); const int c = cur_bid(), G = F.G; const int nheavy = nunits % G;
        if (nheavy > 0 && c >= nheavy) { frame_refresh(F); const int gw0 = F.gw, ngw0 = F.NGW; F.gw = (c - nheavy) * NWAVES + F.wave; F.NGW = (G - nheavy) * NWAVES; convert_wa(F, l + 1); F.gw = gw0; F.NGW = ngw0; }
        else if (nheavy == 0) { frame_refresh(F); convert_wa(F, l + 1); } }
}
__device__ __forceinline__ void phase_g6(Frame& F, const int l) {
    pg8::SchedTiles S{(const bf16_t*)(F.ws + WS_ACT), (const bf16_t*)(F.ws + WS_WDN), DFF, DFF, M / 256, 4, F.G, cur_bid()};
    pg8::EpiOutSq E{(bf16_t*)(F.ws + WS_FO)};
    pg8::gemm_phase<pg8::EpiOutSq, pg8::SchedTiles, false, DFF, DFF, DFF>(F.lds, F.wave, S, E);
}
__device__ __forceinline__ void phase_n2(Frame& F, const int l) {
    const bf16_t* Y = (const bf16_t*)(F.ws + WS_FO); const float* gp = F.inp(I_LPOF) + l * DM;
    if (l == 0) resid_rows<true, true>(F, F.ws + WS_XS, (bf16_t*)F.out + (size_t)M * DM, Y, gp, (unsigned char*)F.out, rsx_ptr(F, 0));
    else resid_rows<true, false>(F, F.ws + WS_XS, F.out, Y, gp, nullptr, nullptr);
}

constexpr int NPHASE = 1 + 9 * DEPTH;
__global__ void __launch_bounds__(NWAVES * 64, 2) mega_fwd(Args args) {
    extern __shared__ __attribute__((aligned(16))) unsigned char lds[];
    Frame F;
    F.lds = (LAS unsigned char*)lds; F.ldsg = (char*)lds;
    F.G = gridDim.x; { const int bx = blockIdx.x; F.vcu = (F.G % 8 == 0) ? (bx % 8) * (F.G / 8) + bx / 8 : bx; }
    F.NGW = F.G * NWAVES; F.wave = __builtin_amdgcn_readfirstlane((int)threadIdx.x >> 6);
    const int lo = args.ph_lo, hi = args.ph_hi;
    volatile LAS unsigned* bst = (volatile LAS unsigned*)(F.lds + MISC_OFF);
    unsigned* bar = (unsigned*)(GAS unsigned*)(args.ws + WS_CTL) + CW_BAR;
    if (threadIdx.x == 0) { bst[0] = 0u; bst[1] = 0u; (void)xb_add(&bar[XB_XCNT(xb_xcc_id())], 1u); }
    __syncthreads();
#define GRID_BAR(ph) do { if (((ph) == 0 && MK_CG_FIRST) || MK_CG_BARRIER) { cg::this_grid().sync(); } else { unsigned* bar_ = (unsigned*)(F.ws + WS_CTL) + CW_BAR; \
        xcd_barrier(bar_, (volatile LAS unsigned*)(F.lds + MISC_OFF), F.wave == 0 && lane_id() == 0, (unsigned)F.G); } } while (0)
#define RUN_PHASE(ph, call) if (lo <= (ph) && (ph) < hi) { frame_refresh(F); call; if ((ph) + 1 < hi) { frame_refresh(F); GRID_BAR(ph); } }
    RUN_PHASE(0, phase_p0(F));
    RUN_PHASE(1, phase_g1(F, 0));  RUN_PHASE(2, phase_prep(F, 0));  RUN_PHASE(3, phase_attn(F, 0));  RUN_PHASE(4, phase_g3(F, 0));  RUN_PHASE(5, phase_g4(F, 0));
    RUN_PHASE(6, phase_n1(F, 0));  RUN_PHASE(7, phase_g5(F, 0));    RUN_PHASE(8, phase_g6(F, 0));    RUN_PHASE(9, phase_n2(F, 0));
    RUN_PHASE(10, phase_g1(F, 1)); RUN_PHASE(11, phase_prep(F, 1)); RUN_PHASE(12, phase_attn(F, 1)); RUN_PHASE(13, phase_g3(F, 1)); RUN_PHASE(14, phase_g4(F, 1));
    RUN_PHASE(15, phase_n1(F, 1)); RUN_PHASE(16, phase_g5(F, 1));   RUN_PHASE(17, phase_g6(F, 1));   RUN_PHASE(18, phase_n2(F, 1));
#undef RUN_PHASE
#undef GRID_BAR
}


#ifndef DBG_STOP
#define DBG_STOP 0
#endif
#if DBG_STOP
__global__ void dbg_fold(const bf16_t* b0, int p0, const bf16_t* b1, int p1, float* out) {
    const size_t i = (size_t)blockIdx.x * 256 + threadIdx.x; const int r = (int)(i >> 10), c = (int)(i & 1023); float s = 0.f;
    for (int j = 0; c + 1024 * j < p0; ++j) s += bf2f(b0[(size_t)r * p0 + c + 1024 * j]);
    if (b1) for (int j = 0; c + 1024 * j < p1; ++j) s += bf2f(b1[(size_t)r * p1 + c + 1024 * j]);
    out[i] = s;
}
#endif
extern "C" void kernel_launch(void* const* d_in, const int* in_sizes, int n_in, void* d_out, int out_size, void* d_ws, size_t ws_size, hipStream_t stream) {
    static int grid = 0;
    if (grid == 0) {
        if (n_in != 19 || in_sizes[0] != M * DM || out_size != M * DM || ws_size < WS_END) { fprintf(stderr, "kernel_launch: unexpected shapes (n_in %d, in0 %d, out %d, ws %zu)\n", n_in, n_in > 0 ? in_sizes[0] : -1, out_size, ws_size); grid = -1; return; }
        int dev = 0, cus = 0, per_cu = 0;
        if (hipGetDevice(&dev) != hipSuccess || hipDeviceGetAttribute(&cus, hipDeviceAttributeMultiprocessorCount, dev) != hipSuccess) { grid = -1; return; }
        if (hipFuncSetAttribute((const void*)mega_fwd, hipFuncAttributeMaxDynamicSharedMemorySize, LDS_BYTES) != hipSuccess) { fprintf(stderr, "kernel_launch: hipFuncSetAttribute failed\n"); grid = -1; return; }
        if (hipOccupancyMaxActiveBlocksPerMultiprocessor(&per_cu, (const void*)mega_fwd, NWAVES * 64, LDS_BYTES) != hipSuccess || per_cu < 1) { fprintf(stderr, "kernel_launch: occupancy query says %d\n", per_cu); per_cu = 1; }
        (void)hipGetLastError();
        grid = cus * (per_cu < 1 ? 1 : 1);
    }
    if (grid < 0) return;
    (void)hipMemsetAsync((char*)d_ws + WS_CTL, 0, CTL_BYTES, stream);
    Args a{};
    for (int i = 0; i < 19; ++i) a.in[i] = (const float*)d_in[i];
    a.out = (float*)d_out; a.ws = (unsigned char*)d_ws;
#if DBG_STOP
    for (int ph = 0; ph < DBG_STOP; ++ph) { a.ph_lo = ph; a.ph_hi = ph + 1; hipLaunchKernelGGL(mega_fwd, dim3(grid), dim3(NWAVES * 64), LDS_BYTES, stream, a); }
    { const bf16_t* b0; int p0; const bf16_t* b1 = nullptr; int p1 = 0; char* w = (char*)d_ws;
      if (DBG_STOP == 1) { b0 = (const bf16_t*)(w + WS_HS); p0 = 1024; }
      else if (DBG_STOP == 2) { b0 = (const bf16_t*)(w + WS_PS); p0 = NPS; b1 = (const bf16_t*)(w + WS_GT); p1 = NGT; }
      else if (DBG_STOP == 3) { b0 = (const bf16_t*)(w + WS_PS); p0 = NPS; b1 = (const bf16_t*)(w + WS_HS); p1 = 1024; }
      else if (DBG_STOP == 4) { b0 = (const bf16_t*)(w + WS_PS); p0 = NPS; }
      else if (DBG_STOP == 5) { b0 = (const bf16_t*)(w + WS_GT); p0 = NGT; }
      else if (DBG_STOP == 6) { b0 = (const bf16_t*)(w + WS_MO); p0 = 1024; }
      else if (DBG_STOP == 7) { b0 = (const bf16_t*)(w + WS_HS); p0 = 1024; }
      else if (DBG_STOP == 8) { b0 = (const bf16_t*)(w + WS_ACT); p0 = DFF; }
      else { b0 = (const bf16_t*)(w + WS_FO); p0 = 1024; }
      hipLaunchKernelGGL(dbg_fold, dim3(M * DM / 256), dim3(256), 0, stream, b0, p0, b1, p1, (float*)d_out); }
#elif MK_PER_PHASE
    for (int ph = 0; ph < NPHASE; ++ph) { a.ph_lo = ph; a.ph_hi = ph + 1; hipLaunchKernelGGL(mega_fwd, dim3(grid), dim3(NWAVES * 64), LDS_BYTES, stream, a); }
#else
    a.ph_lo = 0; a.ph_hi = NPHASE;
    void* kargs[] = {&a};
    const hipError_t e = hipLaunchCooperativeKernel((const void*)mega_fwd, dim3(grid), dim3(NWAVES * 64), kargs, LDS_BYTES, stream);
    if (e != hipSuccess) fprintf(stderr, "kernel_launch: cooperative launch failed: %s (grid %d)\n", hipGetErrorString(e), grid);
#endif
}
```

```cpp
#include <hip/hip_runtime.h>
#include <hip/hip_cooperative_groups.h>
#include <cstdio>
#include <cstdint>
namespace cg = cooperative_groups;

#ifndef MK_PER_PHASE
#define MK_PER_PHASE 0
#endif
#ifndef MK_CG_FIRST
#define MK_CG_FIRST 0
#endif
#ifndef MK_CG_BARRIER
#define MK_CG_BARRIER 0
#endif

#define LAS __attribute__((address_space(3)))
#define GAS __attribute__((address_space(1)))
typedef unsigned short bf16_t;
typedef short bf16x8 __attribute__((ext_vector_type(8)));
typedef short s16x4 __attribute__((ext_vector_type(4)));
typedef float f32x4 __attribute__((ext_vector_type(4)));
typedef float f32x16 __attribute__((ext_vector_type(16)));
typedef unsigned u32x4 __attribute__((ext_vector_type(4)));
typedef unsigned u32x2 __attribute__((ext_vector_type(2)));

constexpr int DM = 1024, SEQ = 4096, NB = 4, M = NB * SEQ, DEPTH = 2;
constexpr int NIN = 6304, NPS = 2304, NGT = 4096, NPROJ = NPS + NGT, DFF = 2816, NGU = 2 * DFF;
constexpr float EPS = 1e-6f;
constexpr float LOG2E = 1.4426950408889634f;
constexpr int C_AQ = 0, C_AK = 256, C_AV = 512, C_BQ = 768, C_BK = 1024, C_BV = 1152, C_CQ = 1280, C_CK = 1536, C_CV = 1664, C_DCQ = 1792, C_DCKV = 2048, C_DKR = 2176;
constexpr size_t MiB = 1u << 20;
constexpr size_t WS_CTL = 0, CTL_BYTES = 1 * MiB;
constexpr size_t WS_RSQ = 252 * MiB;
constexpr size_t WS_TAB = 1 * MiB;
constexpr size_t WS_WIN = 2 * MiB;
constexpr size_t WS_WG8 = WS_WIN + (size_t)NPS * DM * 2;
constexpr size_t WS_WDUP = WS_WIN + (size_t)NPROJ * DM * 2;
constexpr size_t WS_WBR = WS_WDUP + (size_t)1024 * 384 * 2;
constexpr size_t WS_WOUT = WS_WBR + (size_t)4 * 1024 * 256 * 2;
constexpr size_t WS_HS = 20 * MiB;
constexpr size_t WS_QD = WS_HS, WS_KD = WS_HS + 12 * MiB, WS_VD = WS_HS + 24 * MiB;
constexpr size_t WS_PS = 52 * MiB;
constexpr size_t WS_GT = 124 * MiB;
constexpr size_t WS_MO = WS_PS;
constexpr size_t WS_ACT = WS_PS;
constexpr size_t WS_FO = 144 * MiB;
constexpr size_t WS_XS = 176 * MiB;
constexpr size_t WS_WGU = 232 * MiB;
constexpr size_t WS_WDN = 243 * MiB;
constexpr size_t WS_RSX = 253 * MiB;
constexpr size_t WS_END = 254 * MiB;
static_assert(WS_WOUT + (size_t)DM * DM * 2 <= WS_HS, "ws map");
static_assert(WS_ACT + (size_t)M * DFF * 2 <= WS_FO && WS_FO + (size_t)M * DM * 2 <= WS_WGU && WS_WGU + (size_t)NGU * DM * 2 <= WS_WDN && WS_WDN + (size_t)DM * DFF * 2 <= WS_END, "ws map 2");
constexpr int CW_BAR = 4096;

__device__ __forceinline__ unsigned cvt_pk_bf16(float lo, float hi) { unsigned r; asm volatile("v_cvt_pk_bf16_f32 %0, %1, %2" : "=v"(r) : "v"(lo), "v"(hi)); return r; }
__device__ __forceinline__ unsigned f2bf(float f) { unsigned u = __builtin_bit_cast(unsigned, f); return (u + 0x7fffu + ((u >> 16) & 1u)) >> 16; }
__device__ __forceinline__ float bf_lo(unsigned w) { return __uint_as_float(w << 16); }
__device__ __forceinline__ float bf_hi(unsigned w) { return __uint_as_float(w & 0xffff0000u); }
__device__ __forceinline__ float bf2f(bf16_t h) { return __uint_as_float(((unsigned)h) << 16); }
__device__ __forceinline__ float sigmoidf_(float x) { return __builtin_amdgcn_rcpf(1.0f + __builtin_amdgcn_exp2f(-x * LOG2E)); }
__device__ __forceinline__ int lane_id() { unsigned z = 0u; asm volatile("" : "+v"(z)); return (int)__builtin_amdgcn_mbcnt_hi(~0u, __builtin_amdgcn_mbcnt_lo(~0u, z)); }
__device__ __forceinline__ int cur_tid(int wave) { return wave * 64 + lane_id(); }
__device__ __forceinline__ int cur_bid() { int b = blockIdx.x; asm volatile("" : "+s"(b)); return b; }
__device__ __forceinline__ float wave_sum(float v) {
#pragma unroll
    for (int o = 1; o < 64; o <<= 1) v += __shfl_xor(v, o);
    return v;
}

namespace pg8 {
constexpr int BM = 256, BK = 64, HALF = 128, HTB = HALF * BK * 2, STAGE_BYTES = 8 * HTB, NXCD = 8, WGM = 8;
__host__ __device__ __forceinline__ int lds_byte(int r, int c) { const int st = (r >> 4) * 2 + (c >> 5), rr = r & 15, cc = c & 31, ob = rr * 64 + cc * 2; return st * 1024 + (ob ^ (((ob >> 9) & 1) << 5)); }
__host__ __device__ __forceinline__ void stage_rc(int b, int& R, int& C) { const int st = b / 1024, sb = b % 1024, swz = sb ^ (((sb >> 9) & 1) << 5); R = (st >> 1) * 16 + swz / 64; C = (st & 1) * 32 + (swz % 64) / 2; }
__host__ __device__ __forceinline__ int perm32(int rho) { const int n = rho >> 4, i = rho & 15; return 8 * (i >> 2) + 4 * n + (i & 3); }

struct Unit { const char* a; const char* b; int pm, pn, aux, nt; };
__device__ __forceinline__ size_t gate_unit_off(int pm, int pn, int n) { return ((size_t)((pm * 4 + pn) * 4 + n)) << 17; }
__device__ __forceinline__ void tile_of(int L, int nM, int nN, int& pm, int& pn) {
    const int nwg = nM * nN; int wgid = L;
    { const int q = nwg / NXCD, r = nwg % NXCD, xcd = wgid % NXCD, off = wgid / NXCD; wgid = (xcd < r ? xcd * (q + 1) : r * (q + 1) + (xcd - r) * q) + off; }
    const int nig = WGM * nN, gid = wgid / nig, fm = gid * WGM, gsz = (nM - fm) < WGM ? (nM - fm) : WGM;
    pm = fm + ((wgid % nig) % gsz); pn = (wgid % nig) / gsz;
}
struct SchedTiles {
    const bf16_t* A; const bf16_t* Bt; int lda, ldb, nM, nN, G, c, pn_off = 0, slot0 = 0;
    __device__ __forceinline__ bool next(int i, Unit& u) const {
        const long L = (long)i * G + c; if (L >= (long)nM * nN) return false;
        int pm, pn; tile_of((int)L, nM, nN, pm, pn);
        u.pm = pm; u.pn = pn + pn_off; u.aux = slot0 + i; u.a = (const char*)(A + (size_t)pm * BM * lda); u.b = (const char*)(Bt + (size_t)pn * BM * ldb); return true;
    }
};
struct SchedGateBal {
    const bf16_t* A; const bf16_t* Bt; int lda, ldb, G, c, pn_off, slot0;
    __device__ __forceinline__ bool next(int i, Unit& u) const {
        long L;
        if (G == 256) { if (i < 3) L = (long)i * 256 + c; else if (i == 3) { if (c < 64) return false; L = 768 + (c - 64); } else if (i == 4) { if (c < 64 || c >= 128) return false; L = 960 + (c - 64); } else return false; }
        else { L = (long)i * G + c; if (L >= 1024) return false; }
        int pm, pn; tile_of((int)L, 64, 16, pm, pn);
        u.pm = pm; u.pn = pn + pn_off; u.aux = slot0 + i; u.a = (const char*)(A + (size_t)pm * BM * lda); u.b = (const char*)(Bt + (size_t)pn * BM * ldb); return true;
    }
};
constexpr int RSX_LDS = 131072 + 2048;
template <class Sched> __device__ __forceinline__ void fill_rsx_lds(LAS unsigned char* lds, const int tid, const Sched& S, const float* rsx, const int nmax) {
    const int wv = __builtin_amdgcn_readfirstlane(tid >> 6), lane = tid & 63;
    for (int i = wv >> 2; i < nmax; i += 2) { Unit u; if (S.next(i, u)) {
        const int slot = __builtin_amdgcn_readfirstlane(u.aux), pm = __builtin_amdgcn_readfirstlane(u.pm);
        __builtin_amdgcn_global_load_lds((const unsigned*)(rsx + pm * BM + (wv & 3) * 64 + lane), (LAS unsigned*)(lds + RSX_LDS + slot * 1024 + (wv & 3) * 256), 4, 0, 0); } }
}
struct SchedDup {
    const bf16_t* PS; const bf16_t* Wd; int G, c;
    __device__ __forceinline__ bool next(int i, Unit& u) const {
        const long L = (long)i * G + c; if (L >= 256) return false;
        int pm, pn; tile_of((int)L, 64, 4, pm, pn); const bool q = pn < 2;
        u.pm = pm; u.pn = pn; u.aux = 0; u.nt = q ? 4 : 2;
        u.a = (const char*)(PS + (size_t)pm * BM * NPS + (q ? C_DCQ : C_DCKV)); u.b = (const char*)(Wd + (size_t)pn * BM * 384 + (q ? 0 : 256)); return true;
    }
};
struct SchedBranch {
    const bf16_t* PS; const bf16_t* Wbr; int G, c;
    __device__ __forceinline__ bool next(int i, Unit& u) const {
        const int ti = i >> 2, n = i & 3; const long L = (long)ti * G + c; if (L >= 256) return false;
        int pm, pn; tile_of((int)L, 64, 4, pm, pn);
        const int colofs = (n == 0) ? C_AQ : (n == 1) ? C_BQ : (n == 2) ? C_CQ : C_DCQ;
        u.pm = pm; u.pn = pn; u.aux = n; u.a = (const char*)(PS + (size_t)pm * BM * NPS + colofs); u.b = (const char*)(Wbr + ((size_t)n * 1024 + pn * BM) * 256); return true;
    }
};

typedef int v8i __attribute__((ext_vector_type(8)));
typedef int v4i __attribute__((ext_vector_type(4)));
template <class Epi, class Sched, bool ALIGN_EPI, int K, int lda, int ldb, bool FP8 = false, bool VARNT = false>
__device__ __forceinline__ void gemm_phase(LAS unsigned char* lds, const int wid, const Sched& S, const Epi& E) {
    const int lane = lane_id(), tid = wid * 64 + lane, wr = wid >> 2, wc = wid & 3, fr = lane & 15, fq = lane >> 4;
    constexpr int nt_c = K / BK;
    unsigned voffA[2], voffB[2];
#pragma unroll
    for (int i = 0; i < 2; ++i) { int R, C; stage_rc(tid * 16 + i * 8192, R, C); const int Rb = Epi::PERM ? ((R & ~31) + perm32(R & 31)) : R;
        voffA[i] = (unsigned)(R * lda + C) * 2u; voffB[i] = (unsigned)(Rb * ldb + C) * 2u; }
    const size_t kstep = (size_t)(BK * 2);
    const size_t hstepA = (size_t)HALF * lda * 2, hstepB = (size_t)HALF * ldb * 2;
    const unsigned ldsw = (unsigned)wid * 1024u;
    const unsigned basel = (unsigned)lds_byte(fr, fq * 8); const unsigned aoffs = (unsigned)wr * 8192u, boffs = (unsigned)wc * 4096u;
#define PG8_SA(b, h) (((b) * 2 + (h)) * HTB)
#define PG8_SB(b, h) ((4 + (b) * 2 + (h)) * HTB)
#define PG8_STAGE(bufoff, gbase, voff) do { _Pragma("unroll") for (int _i = 0; _i < 2; ++_i) \
        __builtin_amdgcn_global_load_lds((const unsigned*)((const char*)(gbase) + (voff)[_i]), (LAS unsigned*)(lds + (bufoff) + ldsw + _i * 8192), 16, 0, 0); } while (0)
#define PG8_CAT(lo_, hi_) __builtin_shufflevector(lo_, hi_, 0, 1, 2, 3, 4, 5, 6, 7)
#define PG8_LDA(dst, b, h) do { unsigned ad_ = basel + (aoffs + (unsigned)PG8_SA(b, h)); asm volatile("" : "+v"(ad_)); _Pragma("unroll") for (int m = 0; m < 4; ++m) { \
        if constexpr (FP8) dst##8[m] = PG8_CAT(*(const LAS v4i*)(lds + ad_ + m * 2048), *(const LAS v4i*)(lds + ad_ + m * 2048 + 1024)); \
        else { _Pragma("unroll") for (int k = 0; k < 2; ++k) dst[m][k] = *(const LAS bf16x8*)(lds + ad_ + m * 2048 + k * 1024); } } } while (0)
#define PG8_LDB(dst, b, h) do { unsigned ad_ = basel + (boffs + (unsigned)PG8_SB(b, h)); asm volatile("" : "+v"(ad_)); _Pragma("unroll") for (int n = 0; n < 2; ++n) { \
        if constexpr (FP8) dst##8[n] = PG8_CAT(*(const LAS v4i*)(lds + ad_ + n * 2048), *(const LAS v4i*)(lds + ad_ + n * 2048 + 1024)); \
        else { _Pragma("unroll") for (int k = 0; k < 2; ++k) dst[n][k] = *(const LAS bf16x8*)(lds + ad_ + n * 2048 + k * 1024); } } } while (0)
#define PG8_MMA(ai, bj, At, Bt) do { __builtin_amdgcn_s_setprio(1); _Pragma("unroll") for (int m = 0; m < 4; ++m) _Pragma("unroll") for (int n = 0; n < 2; ++n) { \
        if constexpr (FP8) acc[ai][bj][m][n] = __builtin_amdgcn_mfma_scale_f32_16x16x128_f8f6f4(Bt##8[n], At##8[m], acc[ai][bj][m][n], 0, 0, 0, 0x7f7f7f7f, 0, 0x7f7f7f7f); \
        else { _Pragma("unroll") for (int k = 0; k < 2; ++k) acc[ai][bj][m][n] = __builtin_amdgcn_mfma_f32_16x16x32_bf16(Bt[n][k], At[m][k], acc[ai][bj][m][n], 0, 0, 0); } } \
        if constexpr (FP8) asm volatile("" : "+v"(acc[ai][bj][0][0]), "+v"(acc[ai][bj][0][1]), "+v"(acc[ai][bj][1][0]), "+v"(acc[ai][bj][1][1]), "+v"(acc[ai][bj][2][0]), "+v"(acc[ai][bj][2][1]), "+v"(acc[ai][bj][3][0]), "+v"(acc[ai][bj][3][1])); \
        __builtin_amdgcn_s_setprio(0); } while (0)
#define PG8_WAIT_V(n) asm volatile("s_waitcnt vmcnt(" #n ")" ::: "memory")
#define PG8_WAIT_L(n) asm volatile("s_waitcnt lgkmcnt(" #n ")" ::: "memory")
#define PG8_BAR __builtin_amdgcn_s_barrier()
#define PG8_SCHED __builtin_amdgcn_sched_barrier(0)
#define PG8_PIN do { if constexpr (FP8) __builtin_amdgcn_sched_barrier(0); } while (0)
    Unit cur, nxt; int ui = 0;
    if (!S.next(0, cur)) return;
    f32x4 acc[2][2][4][2];
#pragma unroll
    for (int a = 0; a < 2; ++a)
#pragma unroll
        for (int b = 0; b < 2; ++b)
#pragma unroll
            for (int m = 0; m < 4; ++m)
#pragma unroll
                for (int n = 0; n < 2; ++n) acc[a][b][m][n] = (f32x4){0.f, 0.f, 0.f, 0.f};
    bf16x8 At[4][2], B0[2][2], B1[2][2]; v8i At8[4], B08[2], B18[2];
    const char* cA = cur.a; const char* cB = cur.b;
    PG8_STAGE(PG8_SB(0, 0), cB, voffB); PG8_STAGE(PG8_SB(0, 1), cB + hstepB, voffB); PG8_STAGE(PG8_SA(0, 0), cA, voffA); PG8_STAGE(PG8_SA(0, 1), cA + hstepA, voffA);
    if (wr == 1) PG8_BAR;
    PG8_WAIT_V(2); PG8_BAR;
    PG8_STAGE(PG8_SB(1, 0), cB + kstep, voffB); PG8_STAGE(PG8_SA(1, 0), cA + kstep, voffA); PG8_STAGE(PG8_SB(1, 1), cB + hstepB + kstep, voffB);
    PG8_WAIT_V(6); PG8_BAR;
    for (;;) {
        const bool has_next = S.next(ui + 1, nxt);
        const char* nA = has_next ? nxt.a : cA; const char* nB = has_next ? nxt.b : cB;
        const int nt = VARNT ? cur.nt : nt_c;
        for (int t = 0; t < nt; t += 2) {
            const bool last = (t == nt - 2);
            const char* a1 = cA + (size_t)(t + 1) * kstep;
            const char* a2 = last ? nA : cA + (size_t)(t + 2) * kstep; const char* b2 = last ? nB : cB + (size_t)(t + 2) * kstep;
            const char* a3 = a2 + kstep; const char* b3 = b2 + kstep;
            PG8_LDB(B0, 0, 0); PG8_LDB(B1, 0, 1); PG8_SCHED; PG8_LDA(At, 0, 0); PG8_STAGE(PG8_SA(1, 1), a1 + hstepA, voffA);
            PG8_WAIT_V(8); PG8_WAIT_L(0); PG8_BAR; PG8_PIN; PG8_MMA(0, 0, At, B0); PG8_MMA(0, 1, At, B1); PG8_PIN; PG8_BAR; PG8_SCHED;
            PG8_LDA(At, 0, 1); PG8_STAGE(PG8_SB(0, 0), b2, voffB); PG8_STAGE(PG8_SB(0, 1), b2 + hstepB, voffB); PG8_STAGE(PG8_SA(0, 0), a2, voffA);
            PG8_WAIT_V(8); PG8_WAIT_L(0); PG8_BAR; PG8_PIN; PG8_MMA(1, 0, At, B0); PG8_MMA(1, 1, At, B1); PG8_PIN; PG8_BAR; PG8_SCHED;
            PG8_LDB(B0, 1, 0); PG8_LDB(B1, 1, 1); PG8_SCHED; PG8_LDA(At, 1, 0); PG8_STAGE(PG8_SA(0, 1), a2 + hstepA, voffA);
            PG8_WAIT_V(8); PG8_WAIT_L(0); PG8_BAR; PG8_PIN; PG8_MMA(0, 0, At, B0); PG8_MMA(0, 1, At, B1); PG8_PIN; PG8_BAR; PG8_SCHED;
            PG8_LDA(At, 1, 1); PG8_STAGE(PG8_SB(1, 0), b3, voffB); PG8_STAGE(PG8_SB(1, 1), b3 + hstepB, voffB); PG8_STAGE(PG8_SA(1, 0), a3, voffA);
            PG8_WAIT_V(8); PG8_WAIT_L(0); PG8_BAR; PG8_PIN; PG8_MMA(1, 0, At, B0); PG8_MMA(1, 1, At, B1); PG8_PIN; PG8_BAR; PG8_SCHED;
        }
        if constexpr (ALIGN_EPI) { if (wr == 0) PG8_BAR; }
        { const int l2 = lane_id(); E(acc, cur, wr, wc, l2 & 15, l2 >> 4); }
        if (!has_next) break;
        if (!E.keep(cur)) {
#pragma unroll
            for (int a = 0; a < 2; ++a)
#pragma unroll
                for (int b = 0; b < 2; ++b)
#pragma unroll
                    for (int m = 0; m < 4; ++m)
#pragma unroll
                        for (int n = 0; n < 2; ++n) acc[a][b][m][n] = (f32x4){0.f, 0.f, 0.f, 0.f};
        }
        cur = nxt; cA = nA; cB = nB; ++ui;
        if constexpr (ALIGN_EPI) { if (wr == 1) PG8_BAR; }
    }
    PG8_WAIT_V(0);
    if constexpr (!ALIGN_EPI) { if (wr == 0) PG8_BAR; }
    PG8_BAR;
#undef PG8_SA
#undef PG8_SB
#undef PG8_STAGE
#undef PG8_LDA
#undef PG8_LDB
#undef PG8_MMA
#undef PG8_CAT
#undef PG8_WAIT_V
#undef PG8_WAIT_L
#undef PG8_BAR
#undef PG8_SCHED
#undef PG8_PIN
}

typedef f32x4 Acc[2][2][4][2];
__device__ __forceinline__ u32x4 pack8(const f32x4 v0, const f32x4 v1) { u32x4 w; w.x = cvt_pk_bf16(v0[0], v0[1]); w.y = cvt_pk_bf16(v0[2], v0[3]); w.z = cvt_pk_bf16(v1[0], v1[1]); w.w = cvt_pk_bf16(v1[2], v1[3]); return w; }
__device__ __forceinline__ void unpack8(const u32x4 w, f32x4& v0, f32x4& v1) { v0 = (f32x4){bf_lo(w.x), bf_hi(w.x), bf_lo(w.y), bf_hi(w.y)}; v1 = (f32x4){bf_lo(w.z), bf_hi(w.z), bf_lo(w.w), bf_hi(w.w)}; }
__device__ __forceinline__ float sumsq4(const f32x4 v) { return (v[0] * v[0] + v[1] * v[1]) + (v[2] * v[2] + v[3] * v[3]); }

struct EpiProj {
    static constexpr bool PERM = true;
    bf16_t* PS; bf16_t* GT; float* rsq_q; float* rsq_kv; float lsc;
    const LAS float* rsl;
    __device__ __forceinline__ bool keep(const Unit&) const { return false; }
    __device__ __forceinline__ void operator()(Acc& acc, const Unit& u, int wr, int wc, int fr, int fq) const {
        const int row0 = u.pm * BM + wr * 64 + fr; const int rloc = u.aux * 256 + wr * 64 + fr;
        if (u.pn >= 9) {
            const int t = u.pn - 9; const int wave_c = wr * 4 + 2 * (t & 1) + (wc >> 1), lane_c = fr + 16 * (2 * (wc & 1) + (fq >> 1));
            char* gbase = (char*)GT + gate_unit_off(u.pm, t >> 2, 0) + (size_t)wave_c * 16384 + ((t >> 1) & 1) * 1024 + lane_c * 16 + (fq & 1) * 8;
#pragma unroll
            for (int ai = 0; ai < 2; ++ai)
#pragma unroll
                for (int m = 0; m < 4; ++m) { char* gp = gbase + (ai * 4 + m) * 2048;
                    f32x4 s0 = acc[ai][0][m][0], s1 = acc[ai][0][m][1], s2 = acc[ai][1][m][0], s3 = acc[ai][1][m][1];
                    const float ls2 = -lsc * LOG2E * rsl[rloc + ai * HALF + m * 16];
                    f32x4 e0 = s0 * ls2, e1 = s1 * ls2, e2 = s2 * ls2, e3 = s3 * ls2;
#pragma unroll
                    for (int j = 0; j < 4; ++j) { e0[j] = __builtin_amdgcn_exp2f(e0[j]); e1[j] = __builtin_amdgcn_exp2f(e1[j]); e2[j] = __builtin_amdgcn_exp2f(e2[j]); e3[j] = __builtin_amdgcn_exp2f(e3[j]); }
                    const f32x4 d0 = e0 + 1.0f, d1 = e1 + 1.0f, d2 = e2 + 1.0f, d3 = e3 + 1.0f;
                    f32x4 r0, r1, r2;
#pragma unroll
                    for (int j = 0; j < 4; ++j) { r0[j] = __builtin_amdgcn_rcpf(d0[j]); r1[j] = __builtin_amdgcn_rcpf(d1[j]); r2[j] = __builtin_amdgcn_rcpf(d2[j]); s3[j] = __builtin_amdgcn_rcpf(d3[j]); }
                    s0 = d1 * r0; s1 = d2 * r1; s2 = d3 * r2;
                    __builtin_nontemporal_store((u32x2){cvt_pk_bf16(s0[0], s0[1]), cvt_pk_bf16(s0[2], s0[3])}, (u32x2*)(gp)); __builtin_nontemporal_store((u32x2){cvt_pk_bf16(s1[0], s1[1]), cvt_pk_bf16(s1[2], s1[3])}, (u32x2*)(gp + (1 << 17)));
                    __builtin_nontemporal_store((u32x2){cvt_pk_bf16(s2[0], s2[1]), cvt_pk_bf16(s2[2], s2[3])}, (u32x2*)(gp + (2 << 17))); __builtin_nontemporal_store((u32x2){cvt_pk_bf16(s3[0], s3[1]), cvt_pk_bf16(s3[2], s3[3])}, (u32x2*)(gp + (3 << 17))); }
            return;
        }
        const float qs = (u.pn == 0 || u.pn == 3) ? 0.125f * LOG2E : 1.0f;
        const int col0 = u.pn * BM + wc * 32 + 8 * fq;
#pragma unroll
        for (int ai = 0; ai < 2; ++ai)
#pragma unroll
            for (int m = 0; m < 4; ++m) { const int row = row0 + ai * HALF + m * 16; bf16_t* rowp = PS + (size_t)row * NPS + col0; float ss0 = 0.f, ss1 = 0.f; const float rx = rsl[rloc + ai * HALF + m * 16];
#pragma unroll
                for (int bj = 0; bj < 2; ++bj) { f32x4 v0 = acc[ai][bj][m][0] * rx, v1 = acc[ai][bj][m][1] * rx;
                    const float s = sumsq4(v0) + sumsq4(v1); if (bj == 0) ss0 = s; else ss1 = s; v0 = v0 * qs; v1 = v1 * qs;
                    *(u32x4*)(rowp + bj * HALF) = pack8(v0, v1); }
                if (u.pn == 7 || u.pn == 8) { float s = (u.pn == 7) ? (ss0 + ss1) : ss0; s += __shfl_xor(s, 16); s += __shfl_xor(s, 32);
                    if (fq == 0) (u.pn == 7 ? rsq_q : rsq_kv)[row * 4 + wc] = s; } }
    }
};
struct EpiDup {
    static constexpr bool PERM = true;
    bf16_t* QD; bf16_t* KD; bf16_t* VD; const float* rsq_q; const float* rsq_kv; const float2* tab; float eps;
    __device__ __forceinline__ bool keep(const Unit&) const { return false; }
    __device__ __forceinline__ void operator()(Acc& acc, const Unit& u, int wr, int wc, int fr, int fq) const {
        const int row0 = u.pm * BM + wr * 64 + fr;
        if (u.pn < 2) {
#pragma unroll
            for (int ai = 0; ai < 2; ++ai)
#pragma unroll
                for (int m = 0; m < 4; ++m) { const int row = row0 + ai * HALF + m * 16; const int pos = row & (SEQ - 1);
                    const f32x4 pq = *(const f32x4*)(rsq_q + row * 4); const float rq = __builtin_amdgcn_rsqf(fmaf((pq[0] + pq[1]) + (pq[2] + pq[3]), 1.0f / 256.0f, eps)) * (0.10206207261596577f * LOG2E);
#pragma unroll
                    for (int bj = 0; bj < 2; ++bj) { const int cb = u.pn * 8 + bj * 4 + wc;
                        if (cb < 12) { f32x4 v0 = acc[ai][bj][m][0] * rq, v1 = acc[ai][bj][m][1] * rq;
                            if (cb % 3 == 2) {
                                const float2* tp = tab + pos * 16 + 4 * fq;
#pragma unroll
                                for (int j = 0; j < 4; ++j) { const float2 cs = tp[j]; const float a = v0[j], b = v1[j]; v0[j] = a * cs.x - b * cs.y; v1[j] = b * cs.x + a * cs.y; }
                            }
                            *(u32x4*)(QD + (size_t)row * 384 + cb * 32 + 8 * fq) = pack8(v0, v1); } }
                    if (m & 1) asm volatile("" ::: "memory"); }
        } else {
#pragma unroll
            for (int ai = 0; ai < 2; ++ai)
#pragma unroll
                for (int m = 0; m < 4; ++m) { const int row = row0 + ai * HALF + m * 16;
                    const f32x4 pk = *(const f32x4*)(rsq_kv + row * 4); const float rkv = __builtin_amdgcn_rsqf(fmaf((pk[0] + pk[1]) + (pk[2] + pk[3]), 1.0f / 128.0f, eps));
#pragma unroll
                    for (int bj = 0; bj < 2; ++bj) { const int cbk = (u.pn - 2) * 8 + bj * 4 + wc, h = cbk >> 2, part = cbk & 3;
                        const f32x4 v0 = acc[ai][bj][m][0] * rkv, v1 = acc[ai][bj][m][1] * rkv;
                        bf16_t* dst = (part < 2) ? (KD + (size_t)row * 384 + h * 96 + part * 32 + 8 * fq) : (VD + (size_t)row * 256 + h * 64 + (part - 2) * 32 + 8 * fq);
                        *(u32x4*)dst = pack8(v0, v1); }
                    if (m & 1) asm volatile("" ::: "memory"); }
        }
    }
};
struct EpiGate {
    static constexpr bool PERM = true;
    bf16_t* GT;
    __device__ __forceinline__ bool keep(const Unit& u) const { return u.aux < 3; }
    __device__ __forceinline__ void operator()(Acc& acc, const Unit& u, int wr, int wc, int fr, int fq) const {
        const int row0 = u.pm * BM + wr * 64 + fr, n = u.aux; const int col0 = n * 1024 + u.pn * BM + wc * 32 + 8 * fq;
        bf16_t* gp0 = GT + (size_t)row0 * NGT + col0;
        u32x4 G[2][4][2];
#pragma unroll
        for (int ai = 0; ai < 2; ++ai)
#pragma unroll
            for (int m = 0; m < 4; ++m)
#pragma unroll
                for (int bj = 0; bj < 2; ++bj) G[ai][m][bj] = *(const u32x4*)(gp0 + (size_t)(ai * HALF + m * 16) * NGT + bj * HALF);
#pragma unroll
        for (int ai = 0; ai < 2; ++ai)
#pragma unroll
            for (int m = 0; m < 4; ++m)
#pragma unroll
                for (int bj = 0; bj < 2; ++bj) { f32x4 g0, g1; unpack8(G[ai][m][bj], g0, g1);
                    if (n < 3) { acc[ai][bj][m][0] = acc[ai][bj][m][0] * g0; acc[ai][bj][m][1] = acc[ai][bj][m][1] * g1; }
                    else { *(u32x4*)(gp0 + (size_t)(ai * HALF + m * 16) * NGT + bj * HALF) = pack8(acc[ai][bj][m][0] * g0, acc[ai][bj][m][1] * g1); } }
    }
};
struct EpiOutSq {
    static constexpr bool PERM = true;
    bf16_t* O;
    __device__ __forceinline__ bool keep(const Unit&) const { return false; }
    __device__ __forceinline__ void operator()(Acc& acc, const Unit& u, int wr, int wc, int fr, int fq) const {
        const int row0 = u.pm * BM + wr * 64 + fr; const int col0 = u.pn * BM + wc * 32 + 8 * fq;
#pragma unroll
        for (int ai = 0; ai < 2; ++ai)
#pragma unroll
            for (int m = 0; m < 4; ++m) { const int row = row0 + ai * HALF + m * 16; bf16_t* rowp = O + (size_t)row * DM + col0;
#pragma unroll
                for (int bj = 0; bj < 2; ++bj) *(u32x4*)(rowp + bj * HALF) = pack8(acc[ai][bj][m][0], acc[ai][bj][m][1]); }
    }
};
struct EpiSwiglu {
    static constexpr bool PERM = true;
    bf16_t* ACT; const LAS float* rsl;
    __device__ __forceinline__ bool keep(const Unit&) const { return false; }
    __device__ __forceinline__ void operator()(Acc& acc, const Unit& u, int wr, int wc, int fr, int fq) const {
        const int row0 = u.pm * BM + wr * 64 + fr; const int col0 = u.pn * HALF + wc * 32 + 8 * fq; const int rloc = u.aux * 256 + wr * 64 + fr;
#pragma unroll
        for (int ai = 0; ai < 2; ++ai)
#pragma unroll
            for (int m = 0; m < 4; ++m) { const float rx = rsl[rloc + ai * HALF + m * 16];
                f32x4 g0 = acc[ai][0][m][0] * rx, g1 = acc[ai][0][m][1] * rx; const f32x4 u0 = acc[ai][1][m][0] * rx, u1 = acc[ai][1][m][1] * rx;
                f32x4 t0 = g0 * (-LOG2E), t1 = g1 * (-LOG2E);
#pragma unroll
                for (int j = 0; j < 4; ++j) { t0[j] = __builtin_amdgcn_exp2f(t0[j]); t1[j] = __builtin_amdgcn_exp2f(t1[j]); }
                t0 = t0 + 1.0f; t1 = t1 + 1.0f;
#pragma unroll
                for (int j = 0; j < 4; ++j) { t0[j] = __builtin_amdgcn_rcpf(t0[j]); t1[j] = __builtin_amdgcn_rcpf(t1[j]); }
                g0 = (g0 * u0) * t0; g1 = (g1 * u1) * t1;
                *(u32x4*)(ACT + (size_t)(row0 + ai * HALF + m * 16) * DFF + col0) = pack8(g0, g1); }
    }
};

__device__ __forceinline__ void gemm_g3(LAS unsigned char* lds, const int wid, const SchedBranch& S, const char* GTf, bf16_t* MG) {
    const int lane = lane_id(), tid = wid * 64 + lane, wr = wid >> 2, wc = wid & 3, fr = lane & 15, fq = lane >> 4;
    constexpr int lda = NPS, ldb = 256;
    unsigned voffA[2], voffB[2], voffG[2];
#pragma unroll
    for (int i = 0; i < 2; ++i) { int R, C; stage_rc(tid * 16 + i * 8192, R, C); const int Rb = (R & ~31) + perm32(R & 31);
        voffA[i] = (unsigned)(R * lda + C) * 2u; voffB[i] = (unsigned)(Rb * ldb + C) * 2u; voffG[i] = (unsigned)(wid * 16384 + i * 1024 + lane * 16); }
    const size_t kstep = (size_t)(BK * 2);
    const size_t hstepA = (size_t)HALF * lda * 2, hstepB = (size_t)HALF * ldb * 2;
    const unsigned ldsw = (unsigned)wid * 1024u;
    const unsigned basel = (unsigned)lds_byte(fr, fq * 8); const unsigned aoffs = (unsigned)wr * 8192u, boffs = (unsigned)wc * 4096u;
    const unsigned ownl = ldsw + (unsigned)lane * 16u;
#define G3_SA(b, h) (((b) * 2 + (h)) * HTB)
#define G3_SB(b, h) ((4 + (b) * 2 + (h)) * HTB)
#define G3_STAGE(bufoff, gbase, voff) do { _Pragma("unroll") for (int _i = 0; _i < 2; ++_i) \
        __builtin_amdgcn_global_load_lds((const unsigned*)((const char*)(gbase) + (voff)[_i]), (LAS unsigned*)(lds + (bufoff) + ldsw + _i * 8192), 16, 0, 0); } while (0)
#define G3_STAGE_NT(bufoff, gbase, voff) do { _Pragma("unroll") for (int _i = 0; _i < 2; ++_i) \
        __builtin_amdgcn_global_load_lds((const unsigned*)((const char*)(gbase) + (voff)[_i]), (LAS unsigned*)(lds + (bufoff) + ldsw + _i * 8192), 16, 0, 2); } while (0)
#define G3_LDA(dst, b, h) do { unsigned ad_ = basel + (aoffs + (unsigned)G3_SA(b, h)); asm volatile("" : "+v"(ad_)); _Pragma("unroll") for (int m = 0; m < 4; ++m) { \
        _Pragma("unroll") for (int k = 0; k < 2; ++k) dst[m][k] = *(const LAS bf16x8*)(lds + ad_ + m * 2048 + k * 1024); } } while (0)
#define G3_LDB(dst, b, h) do { unsigned ad_ = basel + (boffs + (unsigned)G3_SB(b, h)); asm volatile("" : "+v"(ad_)); _Pragma("unroll") for (int n = 0; n < 2; ++n) { \
        _Pragma("unroll") for (int k = 0; k < 2; ++k) dst[n][k] = *(const LAS bf16x8*)(lds + ad_ + n * 2048 + k * 1024); } } while (0)
#define G3_MMA(ai, bj, At, Bt) do { __builtin_amdgcn_s_setprio(1); _Pragma("unroll") for (int m = 0; m < 4; ++m) _Pragma("unroll") for (int n = 0; n < 2; ++n) { \
        _Pragma("unroll") for (int k = 0; k < 2; ++k) acc[ai][bj][m][n] = __builtin_amdgcn_mfma_f32_16x16x32_bf16(Bt[n][k], At[m][k], acc[ai][bj][m][n], 0, 0, 0); } \
        __builtin_amdgcn_s_setprio(0); } while (0)
#define G3_WAIT_V(n) asm volatile("s_waitcnt vmcnt(" #n ")" ::: "memory")
#define G3_WAIT_L(n) asm volatile("s_waitcnt lgkmcnt(" #n ")" ::: "memory")
#define G3_BAR __builtin_amdgcn_s_barrier()
#define G3_SCHED __builtin_amdgcn_sched_barrier(0)
#define G3_GRD(dst, soff) do { _Pragma("unroll") for (int _i = 0; _i < 2; ++_i) dst[_i] = *(const LAS u32x4*)(lds + (soff) + ownl + _i * 8192); } while (0)
#define G3_GAPPLY(src, gv, s_) do { _Pragma("unroll") for (int _i = 0; _i < 2; ++_i) { f32x4 g0_, g1_; unpack8(src[_i], g0_, g1_); \
        if (nbr < 3) { acc[gv][_i][s_][0] = acc[gv][_i][s_][0] * g0_; acc[gv][_i][s_][1] = acc[gv][_i][s_][1] * g1_; } \
        else { *(u32x4*)(mrow + (size_t)((gv) * HALF + (s_) * 16) * DM + _i * HALF) = pack8(acc[gv][_i][s_][0] * g0_, acc[gv][_i][s_][1] * g1_); \
               acc[gv][_i][s_][0] = (f32x4){0.f, 0.f, 0.f, 0.f}; acc[gv][_i][s_][1] = (f32x4){0.f, 0.f, 0.f, 0.f}; } } } while (0)
    Unit cur, nxt; int ui = 0;
    if (!S.next(0, cur)) return;
    f32x4 acc[2][2][4][2];
#pragma unroll
    for (int a = 0; a < 2; ++a)
#pragma unroll
        for (int b = 0; b < 2; ++b)
#pragma unroll
            for (int m = 0; m < 4; ++m)
#pragma unroll
                for (int n = 0; n < 2; ++n) acc[a][b][m][n] = (f32x4){0.f, 0.f, 0.f, 0.f};
    bf16x8 At[4][2], B0[2][2], B1[2][2]; u32x4 gA[2], gB0[2], gB1[2];
    const char* cA = cur.a; const char* cB = cur.b;
    G3_STAGE(G3_SB(0, 0), cB, voffB); G3_STAGE(G3_SB(0, 1), cB + hstepB, voffB); G3_STAGE(G3_SA(0, 0), cA, voffA); G3_STAGE(G3_SA(0, 1), cA + hstepA, voffA);
    if (wr == 1) G3_BAR;
    G3_WAIT_V(2); G3_BAR;
    G3_STAGE(G3_SB(1, 0), cB + kstep, voffB); G3_STAGE(G3_SA(1, 0), cA + kstep, voffA); G3_STAGE(G3_SB(1, 1), cB + hstepB + kstep, voffB);
    G3_WAIT_V(6); G3_BAR;
    for (;;) {
        const bool has_next = S.next(ui + 1, nxt);
        const char* nA = has_next ? nxt.a : cA; const char* nB = has_next ? nxt.b : cB;
        const char* cG = GTf + gate_unit_off(cur.pm, cur.pn, cur.aux); const int nbr = cur.aux;
        bf16_t* mrow = MG + (size_t)(cur.pm * BM + wr * 64 + fr) * DM + cur.pn * BM + wc * 32 + 8 * fq;
#define G3_GP(gv, s_) (cG + (size_t)(((gv) * 8 + (s_) * 2) * 1024))
        { const char* a1 = cA + kstep; const char* a2 = cA + 2 * kstep; const char* b2 = cB + 2 * kstep; const char* a3 = a2 + kstep; const char* b3 = b2 + kstep;
            G3_LDB(B0, 0, 0); G3_LDB(B1, 0, 1); G3_SCHED; G3_LDA(At, 0, 0); G3_STAGE(G3_SA(1, 1), a1 + hstepA, voffA);
            G3_WAIT_V(8); G3_WAIT_L(0); G3_BAR; G3_MMA(0, 0, At, B0); G3_MMA(0, 1, At, B1); G3_BAR; G3_SCHED;
            G3_LDA(At, 0, 1); G3_STAGE(G3_SB(0, 0), b2, voffB); G3_STAGE(G3_SB(0, 1), b2 + hstepB, voffB); G3_STAGE(G3_SA(0, 0), a2, voffA);
            G3_WAIT_V(8); G3_WAIT_L(0); G3_BAR; G3_MMA(1, 0, At, B0); G3_MMA(1, 1, At, B1); G3_BAR; G3_SCHED;
            G3_LDB(B0, 1, 0); G3_LDB(B1, 1, 1); G3_SCHED; G3_LDA(At, 1, 0); G3_STAGE(G3_SA(0, 1), a2 + hstepA, voffA);
            G3_WAIT_V(8); G3_WAIT_L(0); G3_BAR; G3_MMA(0, 0, At, B0); G3_MMA(0, 1, At, B1); G3_BAR; G3_SCHED;
            G3_LDA(At, 1, 1); G3_STAGE(G3_SB(1, 0), b3, voffB); G3_STAGE(G3_SB(1, 1), b3 + hstepB, voffB); G3_STAGE(G3_SA(1, 0), a3, voffA);
            G3_WAIT_V(8); G3_WAIT_L(0); G3_BAR; G3_MMA(1, 0, At, B0); G3_MMA(1, 1, At, B1); G3_BAR; G3_SCHED; }
        { const char* a1 = cA + 3 * kstep;
            G3_LDB(B0, 0, 0); G3_LDB(B1, 0, 1); G3_SCHED; G3_LDA(At, 0, 0); G3_STAGE(G3_SA(1, 1), a1 + hstepA, voffA);
            G3_WAIT_V(8); G3_WAIT_L(0); G3_BAR; G3_MMA(0, 0, At, B0); G3_MMA(0, 1, At, B1); G3_BAR; G3_SCHED;
            G3_LDA(At, 0, 1); G3_STAGE_NT(G3_SB(0, 0), G3_GP(0, 2), voffG); G3_STAGE_NT(G3_SB(0, 1), G3_GP(0, 3), voffG); G3_STAGE_NT(G3_SA(0, 0), G3_GP(0, 0), voffG);
            G3_WAIT_V(8); G3_WAIT_L(0); G3_BAR; G3_MMA(1, 0, At, B0); G3_MMA(1, 1, At, B1); G3_BAR; G3_SCHED;
            G3_LDB(B0, 1, 0); G3_LDB(B1, 1, 1); G3_SCHED; G3_LDA(At, 1, 0); G3_STAGE_NT(G3_SA(0, 1), G3_GP(0, 1), voffG);
            G3_WAIT_V(8); G3_WAIT_L(0); G3_BAR; G3_MMA(0, 0, At, B0); G3_MMA(0, 1, At, B1); G3_BAR; G3_SCHED;
            G3_LDA(At, 1, 1); G3_STAGE_NT(G3_SB(1, 0), G3_GP(1, 2), voffG); G3_STAGE_NT(G3_SB(1, 1), G3_GP(1, 3), voffG); G3_STAGE_NT(G3_SA(1, 0), G3_GP(1, 0), voffG);
            G3_WAIT_V(8); G3_WAIT_L(0); G3_BAR; G3_MMA(1, 0, At, B0); G3_MMA(1, 1, At, B1); G3_BAR; G3_SCHED; }
        {   G3_GRD(gB0, G3_SB(0, 0)); G3_GRD(gB1, G3_SB(0, 1)); G3_GRD(gA, G3_SA(0, 0)); G3_STAGE_NT(G3_SA(1, 1), G3_GP(1, 1), voffG);
            G3_WAIT_V(8); G3_WAIT_L(0); G3_BAR; G3_GAPPLY(gB0, 0, 2); G3_GAPPLY(gB1, 0, 3); G3_GAPPLY(gA, 0, 0); G3_BAR; G3_SCHED;
            G3_GRD(gA, G3_SA(0, 1)); G3_STAGE(G3_SB(0, 0), nB, voffB); G3_STAGE(G3_SB(0, 1), nB + hstepB, voffB); G3_STAGE(G3_SA(0, 0), nA, voffA);
            G3_WAIT_V(8); G3_WAIT_L(0); G3_BAR; G3_GAPPLY(gA, 0, 1); G3_BAR; G3_SCHED;
            G3_GRD(gB0, G3_SB(1, 0)); G3_GRD(gB1, G3_SB(1, 1)); G3_GRD(gA, G3_SA(1, 0)); G3_STAGE(G3_SA(0, 1), nA + hstepA, voffA);
            G3_WAIT_V(8); G3_WAIT_L(0); G3_BAR; G3_GAPPLY(gB0, 1, 2); G3_GAPPLY(gB1, 1, 3); G3_GAPPLY(gA, 1, 0); G3_BAR; G3_SCHED;
            G3_GRD(gA, G3_SA(1, 1)); G3_STAGE(G3_SB(1, 0), nB + kstep, voffB); G3_STAGE(G3_SB(1, 1), nB + hstepB + kstep, voffB); G3_STAGE(G3_SA(1, 0), nA + kstep, voffA);
            G3_WAIT_V(8); G3_WAIT_L(0); G3_BAR; G3_GAPPLY(gA, 1, 1); G3_BAR; G3_SCHED; }
#undef G3_GP
        if (!has_next) break;
        cur = nxt; cA = nA; cB = nB; ++ui;
    }
    G3_WAIT_V(0);
    if (wr == 0) G3_BAR;
    G3_BAR;
#undef G3_SA
#undef G3_SB
#undef G3_STAGE
#undef G3_STAGE_NT
#undef G3_LDA
#undef G3_LDB
#undef G3_MMA
#undef G3_WAIT_V
#undef G3_WAIT_L
#undef G3_BAR
#undef G3_SCHED
#undef G3_GRD
#undef G3_GAPPLY
}
}

namespace att {
constexpr int NW = 8, QBLK = 32, KVBLK = 64;
constexpr int L_V = 0, L_K = 16384, L_WS = 16384 + 32768, L_TAB = L_WS + 2048, L_BYTES = L_TAB + 4096;
constexpr int TSH_B = 128, TSH_A = 48;
constexpr float THR2 = 8.0f;
constexpr float NEG = -1e30f, MINIT = -1e4f;
#define SBAR() __builtin_amdgcn_sched_barrier(0)
__device__ __forceinline__ int crow(int r, int hi) { return (r & 3) + 8 * (r >> 2) + 4 * hi; }
template <int DQK> __device__ __forceinline__ int k_off(int row, int c) {
    if (DQK == 64) return row * 128 + ((c ^ ((row >> 1) & 7)) << 4);
    else return row * 256 + ((c ^ (row & 15)) << 4);
}
__device__ __forceinline__ int v_st(int k, int c) { return (c >> 5) * 4096 + k * 64 + (c & 31) * 2; }
__device__ __forceinline__ int v_rd_base(int lane) { return (((lane >> 4) & 1) << 5) | ((lane & 3) << 3) | ((4 * (lane >> 5) + ((lane & 15) >> 2)) << 6); }
constexpr int v_rd_off(int d0, int ks, int half) { return d0 * 4096 + ks * 1024 + half * 512; }
template <int OFF> __device__ __forceinline__ s16x4 tr_read(int vb) { s16x4 r; asm volatile("ds_read_b64_tr_b16 %0, %1 offset:%2" : "=&v"(r) : "v"(vb), "i"(OFF) : "memory"); return r; }
template <int D0> __device__ __forceinline__ void pv_one(f32x16& od, int vb, bf16x8 pa0, bf16x8 pa1, bf16x8 pa2, bf16x8 pa3) {
    const s16x4 l0 = tr_read<v_rd_off(D0, 0, 0)>(vb), h0 = tr_read<v_rd_off(D0, 0, 1)>(vb), l1 = tr_read<v_rd_off(D0, 1, 0)>(vb), h1 = tr_read<v_rd_off(D0, 1, 1)>(vb);
    const s16x4 l2 = tr_read<v_rd_off(D0, 2, 0)>(vb), h2 = tr_read<v_rd_off(D0, 2, 1)>(vb), l3 = tr_read<v_rd_off(D0, 3, 0)>(vb), h3 = tr_read<v_rd_off(D0, 3, 1)>(vb);
    asm volatile("s_waitcnt lgkmcnt(0)" ::: "memory"); SBAR();
#define PK(L, H) (bf16x8){L[0], L[1], L[2], L[3], H[0], H[1], H[2], H[3]}
    od = __builtin_amdgcn_mfma_f32_32x32x16_bf16(pa0, PK(l0, h0), od, 0, 0, 0);
    od = __builtin_amdgcn_mfma_f32_32x32x16_bf16(pa1, PK(l1, h1), od, 0, 0, 0);
    od = __builtin_amdgcn_mfma_f32_32x32x16_bf16(pa2, PK(l2, h2), od, 0, 0, 0);
    od = __builtin_amdgcn_mfma_f32_32x32x16_bf16(pa3, PK(l3, h3), od, 0, 0, 0);
#undef PK
}
__device__ __forceinline__ void pv_all(f32x16* o, int vb, bf16x8 pa0, bf16x8 pa1, bf16x8 pa2, bf16x8 pa3) { pv_one<0>(o[0], vb, pa0, pa1, pa2, pa3); pv_one<1>(o[1], vb, pa0, pa1, pa2, pa3); }

typedef short v4i16_t __attribute__((ext_vector_type(4)));
__device__ __forceinline__ s16x4 vtr(const LAS char* p) { return __builtin_bit_cast(s16x4, __builtin_amdgcn_ds_read_tr16_b64_v4i16((LAS v4i16_t*)p)); }
template <int DQK, bool DO_QK, bool DO_PV>
__device__ __forceinline__ void mstep(f32x16& p0, f32x16& p1, f32x16* o, const LAS char* Ks, const LAS char* Vs  , const bf16x8* qr, const float nm  ,
                                      const bf16x8 pa0, const bf16x8 pa1, const bf16x8 pa2, const bf16x8 pa3, const int r32, const int hi) {
    bf16x8 kf[DQK / 8]; s16x4 vl[8], vh[8];
    if (DO_QK) {
#pragma unroll
        for (int d0 = 0; d0 < DQK / 16; ++d0) { const int c = 2 * d0 + hi; kf[2 * d0] = *(const LAS bf16x8*)(Ks + k_off<DQK>(r32, c)); kf[2 * d0 + 1] = *(const LAS bf16x8*)(Ks + k_off<DQK>(32 + r32, c)); } }
    if (DO_PV) {
#pragma unroll
        for (int i = 0; i < 8; ++i) { vl[i] = vtr(Vs + (i >> 2) * 4096 + (i & 3) * 1024); vh[i] = vtr(Vs + (i >> 2) * 4096 + (i & 3) * 1024 + 512); } }
    __builtin_amdgcn_sched_barrier(0);
    if (DO_QK) {
#pragma unroll
        for (int r = 0; r < 16; ++r) { p0[r] = nm; p1[r] = nm; }
#pragma unroll
        for (int d0 = 0; d0 < DQK / 16; ++d0) { p0 = __builtin_amdgcn_mfma_f32_32x32x16_bf16(kf[2 * d0], qr[d0], p0, 0, 0, 0); p1 = __builtin_amdgcn_mfma_f32_32x32x16_bf16(kf[2 * d0 + 1], qr[d0], p1, 0, 0, 0); } }
    if (DO_PV) {
#define VF(i) (bf16x8){vl[i][0], vl[i][1], vl[i][2], vl[i][3], vh[i][0], vh[i][1], vh[i][2], vh[i][3]}
#pragma unroll
        for (int d0 = 0; d0 < 2; ++d0) { o[d0] = __builtin_amdgcn_mfma_f32_32x32x16_bf16(pa0, VF(d0 * 4 + 0), o[d0], 0, 0, 0); o[d0] = __builtin_amdgcn_mfma_f32_32x32x16_bf16(pa1, VF(d0 * 4 + 1), o[d0], 0, 0, 0);
            o[d0] = __builtin_amdgcn_mfma_f32_32x32x16_bf16(pa2, VF(d0 * 4 + 2), o[d0], 0, 0, 0); o[d0] = __builtin_amdgcn_mfma_f32_32x32x16_bf16(pa3, VF(d0 * 4 + 3), o[d0], 0, 0, 0); }
#undef VF
    }
    if (DO_QK) { asm volatile("" : "+v"(p0), "+v"(p1)); }
    if (DO_PV) { asm volatile("" : "+v"(o[0]), "+v"(o[1])); }
    __builtin_amdgcn_sched_barrier(0);
}
struct MP { int ib; int colb; int R; int rs; int rstart; int jlo, jhi; };
template <int MODE> __device__ __forceinline__ void softmax_tile(f32x16& p0, f32x16& p1, float& mhat, float& alpha, float& l_reg, const int j, const MP& mp, const LAS float* tab,
                                                                 bf16x8& pa0, bf16x8& pa1, bf16x8& pa2, bf16x8& pa3) {
    if (MODE == 1) {
        const int base = mp.ib + 64 * j;
#pragma unroll
        for (int r = 0; r < 16; ++r) { const int i0 = base + (r & 3) + 8 * (r >> 2), i1 = i0 + 32;
            p0[r] += tab[i0 + TSH_B]; p1[r] += tab[i1 + TSH_B]; }
    } else if (MODE == 2) {
        const int KR = mp.rstart + j; const int dr = KR - mp.R + 7;
        const int ibase = dr * 31 + 15 + mp.ib;
#pragma unroll
        for (int r = 0; r < 16; ++r) { const int kc0 = (r & 3) + 8 * (r >> 2), kc1 = kc0 + 32;
            const bool ok0 = (unsigned)(mp.colb + kc0) < 16u, ok1 = (unsigned)(mp.colb + kc1) < 16u;
            const float b0 = tab[ibase + kc0 + TSH_A], b1 = tab[ibase + kc1 + TSH_A];
            p0[r] = (p0[r] + b0) + (ok0 ? 0.f : NEG); p1[r] = (p1[r] + b1) + (ok1 ? 0.f : NEG); }
    }
    float pmax = fmaxf(fmaxf(p0[0], p0[1]), p1[0]);
#pragma unroll
    for (int r = 2; r < 16; r += 2) pmax = fmaxf(fmaxf(pmax, p0[r]), p0[r + 1]);
#pragma unroll
    for (int r = 1; r < 15; r += 2) pmax = fmaxf(fmaxf(pmax, p1[r]), p1[r + 1]);
    pmax = fmaxf(pmax, p1[15]);
    { auto rr = __builtin_amdgcn_permlane32_swap(__float_as_uint(pmax), __float_as_uint(pmax), false, false);
      pmax = fmaxf(__uint_as_float(rr[0]), __uint_as_float(rr[1])); }
    if (__builtin_expect(__all(pmax <= THR2), 1)) { alpha = 1.f; }
    else { const float dl = fmaxf(pmax, 0.f); mhat += dl; alpha = __builtin_amdgcn_exp2f(-dl);
#pragma unroll
        for (int r = 0; r < 16; ++r) { p0[r] -= dl; p1[r] -= dl; } }
#pragma unroll
    for (int r = 0; r < 16; ++r) { p0[r] = __builtin_amdgcn_exp2f(p0[r]); p1[r] = __builtin_amdgcn_exp2f(p1[r]); }
    float ps = 0;
#pragma unroll
    for (int r = 0; r < 16; ++r) ps += p0[r];
#pragma unroll
    for (int r = 0; r < 16; ++r) ps += p1[r];
    { auto rr = __builtin_amdgcn_permlane32_swap(__float_as_uint(ps), __float_as_uint(ps), false, false);
      ps = __uint_as_float(rr[0]) + __uint_as_float(rr[1]); }
    l_reg = l_reg * alpha + ps;
#define PK8(P, B) __builtin_bit_cast(bf16x8, (u32x4){cvt_pk_bf16(P[B], P[B + 1]), cvt_pk_bf16(P[B + 2], P[B + 3]), cvt_pk_bf16(P[B + 4], P[B + 5]), cvt_pk_bf16(P[B + 6], P[B + 7])})
    pa0 = PK8(p0, 0); pa1 = PK8(p0, 8); pa2 = PK8(p1, 0); pa3 = PK8(p1, 8);
#undef PK8
}
template <int DQK> __device__ __forceinline__ void qkt(f32x16& p0, f32x16& p1, const LAS char* Ks, const bf16x8* qr, const f32x16& negm, int r32, int hi) {
    p0 = negm; p1 = negm;
#pragma unroll
    for (int d0 = 0; d0 < DQK / 16; ++d0) { const int c = 2 * d0 + hi;
        const bf16x8 b0 = *(const LAS bf16x8*)(Ks + k_off<DQK>(r32, c));
        const bf16x8 b1 = *(const LAS bf16x8*)(Ks + k_off<DQK>(32 + r32, c));
        p0 = __builtin_amdgcn_mfma_f32_32x32x16_bf16(b0, qr[d0], p0, 0, 0, 0);
        p1 = __builtin_amdgcn_mfma_f32_32x32x16_bf16(b1, qr[d0], p1, 0, 0, 0); }
}
template <int DQK, int MODE>
__device__ __forceinline__ void attn_unit(const bf16_t* __restrict__ Qb, const int ldq, const bf16_t* __restrict__ Kh, const int ldk, const bf16_t* __restrict__ Vh, const int ldv,
                                          bf16_t* Ob, const int ldo, const int kstart, const int NT, const float m_init, const float l_init, const MP mp, LAS char* lds, const int wid) {
    const int lane = lane_id(), tid = wid * 64 + lane, r32 = lane & 31, hi = lane >> 5; const int hb = wid >> 2;
    constexpr int KBUF = 16384, VBUF = 8192;
    LAS char* V_lds = lds + L_V; LAS char* K_lds = lds + L_K;
    LAS float* ws = (LAS float*)(lds + L_WS) + wid * 64; LAS float* li_l = ws; LAS float* al_l = ws + 32;
    const LAS float* tab = (const LAS float*)(lds + L_TAB);
    float mhat = m_init, l_reg = l_init; f32x16 o[2] = {}; bf16x8 qr[DQK / 16];
    const bf16_t* Qw = Qb + (size_t)(wid * QBLK + r32) * ldq + hi * 8;
#pragma unroll
    for (int d0 = 0; d0 < DQK / 16; ++d0) qr[d0] = *reinterpret_cast<const bf16x8*>(Qw + d0 * 16);
    const int sr = tid >> 3, sc = tid & 7, sr2 = (tid & 255) >> 2, sc2 = 8 + (tid & 3);
    const int kst0 = k_off<DQK>(sr, sc), kst2 = (DQK == 96) ? k_off<DQK>(sr2, sc2) : 0, vst0 = v_st(sr, sc * 8);
    const int vrb = v_rd_base(lane);
    const bf16_t* Kg = Kh + (size_t)(kstart + sr) * ldk + sc * 8; const bf16_t* Kg2 = Kh + (size_t)(kstart + sr2) * ldk + sc2 * 8; const bf16_t* Vg = Vh + (size_t)(kstart + sr) * ldv + sc * 8;
    bf16x8 skA, sk2A, svA, skB, sk2B, svB;
#define KLOAD(K_, K2_, t) do { if ((t) < NT) { K_ = *reinterpret_cast<const bf16x8*>(Kg + (size_t)(t) * KVBLK * ldk); if (DQK == 96) K2_ = *reinterpret_cast<const bf16x8*>(Kg2 + (size_t)(t) * KVBLK * ldk); } } while (0)
#define VLOAD(V_, t) do { if ((t) < NT) V_ = *reinterpret_cast<const bf16x8*>(Vg + (size_t)(t) * KVBLK * ldv); } while (0)
#define KWRITE(K_, K2_, t) do { if ((t) < NT) { *(LAS bf16x8*)(K_lds + ((t) & 1) * KBUF + kst0) = K_; if (DQK == 96) *(LAS bf16x8*)(K_lds + ((t) & 1) * KBUF + kst2) = K2_; } } while (0)
#define VWRITE(V_, t) do { if ((t) < NT) *(LAS bf16x8*)(V_lds + ((t) & 1) * VBUF + vst0) = V_; } while (0)
#define STEP_BAR() do { asm volatile("s_waitcnt lgkmcnt(0)" ::: "memory"); __builtin_amdgcn_s_barrier(); asm volatile("" ::: "memory"); } while (0)
#define RESC(a) do { if (__any((a) < 1.f)) { if (hi == 0) al_l[r32] = (a); asm volatile("s_waitcnt lgkmcnt(0)" ::: "memory"); \
    _Pragma("unroll") for (int d = 0; d < 2; ++d) _Pragma("unroll") for (int r = 0; r < 16; ++r) o[d][r] *= al_l[crow(r, hi)]; } } while (0)
    const int jlo = __builtin_amdgcn_readfirstlane(mp.jlo), jhi = __builtin_amdgcn_readfirstlane(mp.jhi);
#define ACT(t) (MODE == 0 || ((t) >= jlo && (t) < jhi))
    f32x16 p0, p1; float al; bf16x8 pa0, pa1, pa2, pa3;
    KLOAD(skA, sk2A, 0); KWRITE(skA, sk2A, 0);
    if (hb) { KLOAD(skB, sk2B, 1); VLOAD(svB, 0); KWRITE(skB, sk2B, 1); VWRITE(svB, 0); }
    KLOAD(skA, sk2A, 1 + hb); VLOAD(svA, hb); KLOAD(skB, sk2B, 2 + hb); VLOAD(svB, 1 + hb);
    STEP_BAR();
    if (hb) STEP_BAR();
#define MSTEP(t) do { const bool q_ = ACT(t), v_ = (t) > 0 && ACT((t) - 1); const LAS char* Ks_ = K_lds + ((t) & 1) * KBUF; const LAS char* Vs_ = V_lds + (((t) - 1) & 1) * VBUF + vrb; \
        if (q_ && v_) mstep<DQK, true, true>(p0, p1, o, Ks_, Vs_, qr, -mhat, pa0, pa1, pa2, pa3, r32, hi); \
        else if (q_) mstep<DQK, true, false>(p0, p1, o, Ks_, Vs_, qr, -mhat, pa0, pa1, pa2, pa3, r32, hi); \
        else if (v_) mstep<DQK, false, true>(p0, p1, o, Ks_, Vs_, qr, -mhat, pa0, pa1, pa2, pa3, r32, hi); STEP_BAR(); } while (0)
#define VSTEP(t, K_, K2_, V_) do { if (ACT(t)) { softmax_tile<MODE>(p0, p1, mhat, al, l_reg, (t), mp, tab, pa0, pa1, pa2, pa3); RESC(al); } \
        KWRITE(K_, K2_, (t) + 1 + hb); VWRITE(V_, (t) + hb); KLOAD(K_, K2_, (t) + 3 + hb); VLOAD(V_, (t) + 2 + hb); STEP_BAR(); } while (0)
    if (hb) __builtin_amdgcn_s_setprio(1);
    for (int t = 0; t < NT; t += 2) {
        MSTEP(t);     VSTEP(t, skA, sk2A, svA);
        MSTEP(t + 1); VSTEP(t + 1, skB, sk2B, svB);
    }
    if (ACT(NT - 1)) mstep<DQK, false, true>(p0, p1, o, K_lds, V_lds + ((NT - 1) & 1) * VBUF + vrb, qr, -mhat, pa0, pa1, pa2, pa3, r32, hi);
    STEP_BAR();
    if (!hb) STEP_BAR();
    __builtin_amdgcn_s_setprio(0);
#undef MSTEP
#undef VSTEP
#undef ACT
    if (hi == 0) li_l[r32] = l_reg; asm volatile("s_waitcnt lgkmcnt(0)" ::: "memory");
    float rli[16];
#pragma unroll
    for (int r = 0; r < 16; ++r) rli[r] = __builtin_amdgcn_rcpf(li_l[crow(r, hi)]);
    bf16_t* Ow = Ob + (size_t)(wid * QBLK) * ldo;
    {
        LAS bf16_t* stg = (LAS bf16_t*)(K_lds + wid * 4096);
#pragma unroll
        for (int r = 0; r < 16; ++r) { const int orow = crow(r, hi);
#pragma unroll
            for (int d0 = 0; d0 < 2; ++d0) stg[orow * 64 + d0 * 32 + r32] = (bf16_t)f2bf(o[d0][r] * rli[r]); }
        asm volatile("s_waitcnt lgkmcnt(0)" ::: "memory");
#pragma unroll
        for (int i = 0; i < 4; ++i) { const int row = i * 8 + (lane >> 3), ch = lane & 7; const u32x4 v = *(const LAS u32x4*)(stg + row * 64 + ch * 8); *(u32x4*)(Ow + (size_t)row * ldo + ch * 8) = v; }
    }
    __syncthreads();
#undef KLOAD
#undef VLOAD
#undef KWRITE
#undef VWRITE
#undef STEP_BAR
#undef RESC
}
#undef SBAR
}


#define XB_TMO      128
#define XB_XCNT(j)  (256  + 64 * (j))
#define XB_XSUB(j)  (1280 + 64 * (j))
#define XB_XGEN(j)  (2304 + 64 * (j))
#define XB_TOP      3328
#define XB_TOPGEN   3392
#define XCD_BAR_WORDS 3456
#define XB_SPIN_CAP (1u << 20)
__device__ __forceinline__ unsigned xb_ld(unsigned* p)              { return __hip_atomic_load(p, __ATOMIC_RELAXED, __HIP_MEMORY_SCOPE_AGENT); }
__device__ __forceinline__ unsigned xb_add(unsigned* p, unsigned v) { return __hip_atomic_fetch_add(p, v, __ATOMIC_RELAXED, __HIP_MEMORY_SCOPE_AGENT); }
__device__ __forceinline__ unsigned xb_xcc_id() { return (unsigned)__builtin_amdgcn_s_getreg((3 << 11) | 20) & 0xFu; }
#define XB_SPIN(cond, bar) do { unsigned _sp = 0; while (cond) { __builtin_amdgcn_s_sleep(1); \
    if ((++_sp & 255u) == 0u) { if (xb_ld(&(bar)[XB_TMO])) break; if (_sp > XB_SPIN_CAP) { atomicAdd(&(bar)[XB_TMO], 1u); break; } } } } while (0)
__device__ __forceinline__ void xcd_barrier_complete(unsigned* bar, unsigned x, unsigned G, unsigned& nloc, unsigned& nx) {
    unsigned sum, cnt, mine, sp = 0u;
    for (;;) {
        sum = 0u; cnt = 0u; mine = 0u;
#pragma unroll
        for (unsigned j = 0; j < 16; ++j) { const unsigned c = xb_ld(&bar[XB_XCNT(j)]); sum += c; cnt += (c > 0u) ? 1u : 0u; mine = (j == x) ? c : mine; }
        if (sum == G) break;
        __builtin_amdgcn_s_sleep(1);
        if ((++sp & 255u) == 0u) { if (xb_ld(&bar[XB_TMO])) break; if (sp > XB_SPIN_CAP) { atomicAdd(&bar[XB_TMO], 1u); break; } }
    }
    nloc = mine > 0u ? mine : 1u; nx = cnt > 0u ? cnt : 1u;
}
__device__ __forceinline__ void xcd_barrier(unsigned* bar, volatile LAS unsigned* st, const bool leader_thread, const unsigned G) {
    asm volatile("s_waitcnt vmcnt(0)" ::: "memory");
    __syncthreads();
    if (leader_thread) {
        const unsigned x = xb_xcc_id();
        __builtin_amdgcn_s_waitcnt(0);
        unsigned nloc = st[0], nx = st[1];
        if (nloc == 0u) { xcd_barrier_complete(bar, x, G, nloc, nx); st[0] = nloc; st[1] = nx; }
        const unsigned old = xb_add(&bar[XB_XSUB(x)], 1u);
        const unsigned gen = old / nloc;
        if (old + 1u == (gen + 1u) * nloc) {
            __builtin_amdgcn_fence(__ATOMIC_RELEASE, "agent");
            asm volatile("s_waitcnt vmcnt(0)" ::: "memory");
            asm volatile("buffer_inv sc1" ::: "memory");
            const unsigned og = xb_add(&bar[XB_TOP], 1u);
            const unsigned tg = og / nx;
            if (og + 1u == (tg + 1u) * nx) xb_add(&bar[XB_TOPGEN], 1u);
            else XB_SPIN(xb_ld(&bar[XB_TOPGEN]) == tg, bar);
            asm volatile("s_waitcnt vmcnt(0)" ::: "memory");
            xb_add(&bar[XB_XGEN(x)], 1u);
            asm volatile("s_waitcnt vmcnt(0)" ::: "memory");
        } else {
            asm volatile("buffer_inv sc1" ::: "memory");
            XB_SPIN(xb_ld(&bar[XB_XGEN(x)]) == gen, bar);
            asm volatile("s_waitcnt vmcnt(0)" ::: "memory");
        }
    }
    __syncthreads();
}

constexpr int NWAVES = 8;
constexpr int LDS_BYTES = 147456;
constexpr int RING_BYTES = 131072, MISC_OFF = RING_BYTES + 1024;
#define KAS __attribute__((address_space(4)))
struct Args { const float* in[19]; float* out; unsigned char* ws; int ph_lo, ph_hi; };
struct Frame {
    LAS unsigned char* lds; char* ldsg;
    int wave, vcu, G, gw, NGW;
    KAS const unsigned long long* ka; float* out; unsigned char* ws;
    __device__ __forceinline__ const float* inp(int i) const { return (const float*)(GAS const float*)ka[i]; }
};
__device__ __forceinline__ void frame_refresh(Frame& F) {
    { int w = F.wave; asm volatile("" : "+s"(w)); F.wave = w; }
    KAS const unsigned long long* ka = (KAS const unsigned long long*)__builtin_amdgcn_kernarg_segment_ptr(); asm volatile("" : "+s"(ka));
    F.ka = ka; F.out = (float*)(GAS float*)ka[19]; F.ws = (unsigned char*)(GAS unsigned char*)ka[20];
    F.gw = F.vcu * NWAVES + F.wave;
}
constexpr int I_X = 0, I_WIN = 1, I_RPB = 2, I_SINK = 3, I_T5 = 4, I_CQN = 5, I_CKN = 6, I_DQN = 7, I_DKVN = 8, I_DWQ = 9, I_DWKV = 10, I_WBR = 11, I_WOUT = 12,
              I_LPM = 13, I_LPOM = 14, I_LPF = 15, I_LPOF = 16, I_WGU = 17, I_WDN = 18;

template <class Fn, bool FP8OUT>
__device__ __forceinline__ void tr_items_t(Frame& Fr, const Fn f, const float scale, const int Kd, const int Nd, void* WT, const int ldd, int& itbase) {
    const int nblk = Nd / 64, nitems = (Kd / 64) * nblk, lane = lane_id();
    int first = (Fr.gw - (itbase % Fr.NGW) + Fr.NGW) % Fr.NGW;
    for (int it = first; it < nitems; it += Fr.NGW) {
        const int kb = it / nblk, nb = it % nblk, k0 = 64 * kb, n = 64 * nb + lane;
        const float* src; int stride; const float* ksc;
        const bool valid = f.src(k0, n, src, stride, ksc);
        float v[64];
#pragma unroll
        for (int j = 0; j < 64; ++j) v[j] = 0.f;
        if (valid) {
#pragma unroll
            for (int j = 0; j < 64; ++j) v[j] = __builtin_nontemporal_load(src + (size_t)j * stride);
            if (ksc) {
#pragma unroll
                for (int j = 0; j < 64; ++j) v[j] *= ksc[j]; }
        }
        if (FP8OUT) {
            u32x4* dst = (u32x4*)((unsigned char*)WT + (size_t)n * ldd + k0);
#pragma unroll
            for (int g = 0; g < 4; ++g) { int w[4];
#pragma unroll
                for (int q = 0; q < 4; ++q) { int x = 0; x = __builtin_amdgcn_cvt_pk_fp8_f32(v[16 * g + 4 * q] * scale, v[16 * g + 4 * q + 1] * scale, x, false); x = __builtin_amdgcn_cvt_pk_fp8_f32(v[16 * g + 4 * q + 2] * scale, v[16 * g + 4 * q + 3] * scale, x, true); w[q] = x; }
                dst[g] = (u32x4){(unsigned)w[0], (unsigned)w[1], (unsigned)w[2], (unsigned)w[3]}; }
        } else {
            u32x4* dst = (u32x4*)((bf16_t*)WT + (size_t)n * ldd + k0);
#pragma unroll
            for (int g = 0; g < 8; ++g) { u32x4 o; o.x = cvt_pk_bf16(v[8 * g], v[8 * g + 1]); o.y = cvt_pk_bf16(v[8 * g + 2], v[8 * g + 3]); o.z = cvt_pk_bf16(v[8 * g + 4], v[8 * g + 5]); o.w = cvt_pk_bf16(v[8 * g + 6], v[8 * g + 7]); dst[g] = o; }
        }
    }
    itbase += nitems;
}
template <class Fn> __device__ __forceinline__ void tr_items(Frame& Fr, const Fn f, const int Kd, const int Nd, bf16_t* WT, const int ldd, int& itbase) { tr_items_t<Fn, false>(Fr, f, 1.0f, Kd, Nd, WT, ldd, itbase); }
template <class Fn> __device__ __forceinline__ void tr_items8(Frame& Fr, const Fn f, const float scale, const int Kd, const int Nd, unsigned char* WT, const int ldd, int& itbase) { tr_items_t<Fn, true>(Fr, f, scale, Kd, Nd, WT, ldd, itbase); }
__device__ __forceinline__ int win_col(int n) { if (n < 2208) return n; if (n < NPS) return -1; const int t = (n - NPS) >> 8, c = (n - NPS) & 255;
    const int g = 2 * (c >> 7) + ((c >> 2) & 1), d = 64 * t + 16 * ((c >> 5) & 3) + 4 * ((c >> 3) & 3) + (c & 3); return 2208 + g * 1024 + d; }
struct FnWin { const float* W; int noff; const float* gk;
    __device__ __forceinline__ bool src(int k0, int n, const float*& p, int& st, const float*& ks) const { const int sc = win_col(n + noff); p = W + (size_t)k0 * NIN + (sc < 0 ? 0 : sc); st = NIN; ks = gk + k0; return sc >= 0; } };
struct FnDup { const float* Wq; const float* Wkv; const float* gq; const float* gkv;
    __device__ __forceinline__ bool src(int k0, int n, const float*& p, int& st, const float*& ks) const {
        if (n < 384) { const int h = n / 96, w = n % 96; int sc; if (w < 64) sc = 96 * h + w; else { const int q = w - 64; sc = 96 * h + 64 + 4 * (q >> 3) + (q & 3) + 16 * ((q >> 2) & 1); }
            const bool ok = k0 < 256; p = Wq + (size_t)(ok ? k0 : 0) * 384 + sc; st = 384; ks = gq + (ok ? k0 : 0); return ok; }
        const bool ok = (n >= 512) && (k0 >= 256); p = Wkv + (size_t)(ok ? k0 - 256 : 0) * 512 + (ok ? n - 512 : 0); st = 512; ks = gkv + (ok ? k0 - 256 : 0); return ok; } };
struct FnBr { const float* W; __device__ __forceinline__ bool src(int k0, int n, const float*& p, int& st, const float*& ks) const { const int nb = n >> 10, d = n & 1023; p = W + ((size_t)nb * 256 + k0) * DM + d; st = DM; ks = nullptr; return true; } };
struct FnPlain { const float* W; int N, off; __device__ __forceinline__ bool src(int k0, int n, const float*& p, int& st, const float*& ks) const { p = W + (size_t)k0 * N + n + off; st = N; ks = nullptr; return true; } };
struct FnGu { const float* W; const float* gk;
    __device__ __forceinline__ bool src(int k0, int n, const float*& p, int& st, const float*& ks) const { const int pn = n >> 8, w = n & 255; const int sc = (w < 128) ? (128 * pn + w) : (DFF + 128 * pn + (w - 128));
        p = W + (size_t)k0 * NGU + sc; st = NGU; ks = gk + k0; return true; } };
__device__ __forceinline__ void convert_wa(Frame& F, const int l) {
    int itbase = 0;
    tr_items(F, FnWin{F.inp(I_WIN) + (size_t)l * DM * NIN, 0, F.inp(I_LPM) + l * DM}, DM, NPS, (bf16_t*)(F.ws + WS_WIN), DM, itbase);
    tr_items8(F, FnWin{F.inp(I_WIN) + (size_t)l * DM * NIN, NPS, F.inp(I_LPM) + l * DM}, 32.0f, DM, NGT, (unsigned char*)(F.ws + WS_WG8), DM, itbase);
    tr_items(F, FnDup{F.inp(I_DWQ) + (size_t)l * 256 * 384, F.inp(I_DWKV) + (size_t)l * 128 * 512, F.inp(I_DQN) + l * 256, F.inp(I_DKVN) + l * 128}, 384, 1024, (bf16_t*)(F.ws + WS_WDUP), 384, itbase);
    tr_items(F, FnBr{F.inp(I_WBR) + (size_t)l * 4 * 256 * DM}, 256, 4096, (bf16_t*)(F.ws + WS_WBR), 256, itbase);
    tr_items(F, FnPlain{F.inp(I_WOUT) + (size_t)l * DM * DM, DM, 0}, DM, DM, (bf16_t*)(F.ws + WS_WOUT), DM, itbase);
}
__device__ __forceinline__ void convert_wb(Frame& F, const int l) {
    int itbase = 0;
    tr_items(F, FnGu{F.inp(I_WGU) + (size_t)l * DM * NGU, F.inp(I_LPF) + l * DM}, DM, NGU, (bf16_t*)(F.ws + WS_WGU), DM, itbase);
    tr_items(F, FnPlain{F.inp(I_WDN) + (size_t)l * DFF * DM, DM, 0}, DFF, DM, (bf16_t*)(F.ws + WS_WDN), DFF, itbase);
}
constexpr int RB = 4;
__device__ __forceinline__ void store_x_row(const int lane, const f32x4 (&v)[4], bf16_t* xrow, unsigned char* x8row) {
#pragma unroll
    for (int j = 0; j < 4; ++j) { const f32x4 y = v[j];
        if (xrow) ((unsigned long long*)xrow + lane)[64 * j] = (unsigned long long)cvt_pk_bf16(y[0], y[1]) | ((unsigned long long)cvt_pk_bf16(y[2], y[3]) << 32);
        if (x8row) { int x = 0; x = __builtin_amdgcn_cvt_pk_fp8_f32(y[0], y[1], x, false); x = __builtin_amdgcn_cvt_pk_fp8_f32(y[2], y[3], x, true); ((int*)x8row)[lane + 64 * j] = x; } }
}
__device__ __forceinline__ void cast_rows(Frame& F, const float* x, bf16_t* XB, unsigned char* X8, float* rsx) {
    const int lane = lane_id();
    for (int m0 = F.gw; m0 < M; m0 += RB * F.NGW) {
        f32x4 v[RB][4]; float ss[RB];
#pragma unroll
        for (int r = 0; r < RB; ++r) { const int m = m0 + r * F.NGW;
#pragma unroll
            for (int j = 0; j < 4; ++j) v[r][j] = __builtin_nontemporal_load((const f32x4*)(x + (size_t)m * DM) + lane + 64 * j); }
#pragma unroll
        for (int r = 0; r < RB; ++r) { float s = 0.f;
#pragma unroll
            for (int j = 0; j < 4; ++j) s += pg8::sumsq4(v[r][j]);
            ss[r] = s; }
#pragma unroll
        for (int o = 1; o < 64; o <<= 1) {
#pragma unroll
            for (int r = 0; r < RB; ++r) ss[r] += __shfl_xor(ss[r], o); }
#pragma unroll
        for (int r = 0; r < RB; ++r) { const int m = m0 + r * F.NGW; store_x_row(lane, v[r], XB + (size_t)m * DM, X8 + (size_t)m * DM);
            if (lane == 0) rsx[m] = __builtin_amdgcn_rsqf(ss[r] * (1.0f / DM) + EPS); }
    }
}
template <bool XIN_BF, bool XOUT_BF>
__device__ __forceinline__ void resid_rows(Frame& F, const void* xin_, void* xout_, const bf16_t* Y, const float* gpost, unsigned char* X8, float* rsx) {
    const int lane = lane_id(); f32x4 gp[4];
#pragma unroll
    for (int j = 0; j < 4; ++j) gp[j] = *((const f32x4*)gpost + lane + 64 * j);
    for (int m0 = F.gw; m0 < M; m0 += RB * F.NGW) {
        f32x4 v[RB][4]; u32x2 yw[RB][4]; float ss[RB];
#pragma unroll
        for (int r = 0; r < RB; ++r) { const int m = m0 + r * F.NGW;
#pragma unroll
            for (int j = 0; j < 4; ++j) yw[r][j] = __builtin_nontemporal_load((const u32x2*)(Y + (size_t)m * DM) + lane + 64 * j); }
#pragma unroll
        for (int r = 0; r < RB; ++r) { const int m = m0 + r * F.NGW;
#pragma unroll
            for (int j = 0; j < 4; ++j) {
                if (XIN_BF) { const u32x2 xw = __builtin_nontemporal_load((const u32x2*)((const bf16_t*)xin_ + (size_t)m * DM) + lane + 64 * j); v[r][j] = (f32x4){bf_lo(xw.x), bf_hi(xw.x), bf_lo(xw.y), bf_hi(xw.y)}; }
                else v[r][j] = __builtin_nontemporal_load((const f32x4*)((const float*)xin_ + (size_t)m * DM) + lane + 64 * j); } }
#pragma unroll
        for (int r = 0; r < RB; ++r) { float s = 0.f;
#pragma unroll
            for (int j = 0; j < 4; ++j) { const float a = bf_lo(yw[r][j].x), b = bf_hi(yw[r][j].x), c = bf_lo(yw[r][j].y), d = bf_hi(yw[r][j].y); s += (a * a + b * b) + (c * c + d * d); }
            ss[r] = s; }
#pragma unroll
        for (int o = 1; o < 64; o <<= 1) {
#pragma unroll
            for (int r = 0; r < RB; ++r) ss[r] += __shfl_xor(ss[r], o); }
#pragma unroll
        for (int r = 0; r < RB; ++r) { const int m = m0 + r * F.NGW; const float rstd = __builtin_amdgcn_rsqf(ss[r] * (1.0f / DM) + EPS); float s2 = 0.f;
#pragma unroll
            for (int j = 0; j < 4; ++j) { const f32x4 yv = (f32x4){bf_lo(yw[r][j].x), bf_hi(yw[r][j].x), bf_lo(yw[r][j].y), bf_hi(yw[r][j].y)};
                v[r][j] = v[r][j] + yv * rstd * gp[j];
                if (XOUT_BF) *((u32x2*)((bf16_t*)xout_ + (size_t)m * DM) + lane + 64 * j) = (u32x2){cvt_pk_bf16(v[r][j][0], v[r][j][1]), cvt_pk_bf16(v[r][j][2], v[r][j][3])};
                else __builtin_nontemporal_store(v[r][j], (f32x4*)((float*)xout_ + (size_t)m * DM) + lane + 64 * j);
                s2 += pg8::sumsq4(v[r][j]); }
            ss[r] = s2;
            if (X8) store_x_row(lane, v[r], nullptr, X8 + (size_t)m * DM); }
        if (rsx) {
#pragma unroll
            for (int o = 1; o < 64; o <<= 1) {
#pragma unroll
                for (int r = 0; r < RB; ++r) ss[r] += __shfl_xor(ss[r], o); }
#pragma unroll
            for (int r = 0; r < RB; ++r) if (lane == 0) rsx[m0 + r * F.NGW] = __builtin_amdgcn_rsqf(ss[r] * (1.0f / DM) + EPS);
        }
    }
}

__device__ __forceinline__ float* rsx_ptr(Frame& F, int kind) { return (float*)(F.ws + WS_RSX) + (size_t)kind * M; }
__device__ __forceinline__ void phase_p0(Frame& F) {
    { const int lane = lane_id(); float2* tab = (float2*)(F.ws + WS_TAB);
      for (int e = F.gw * 64 + lane; e < SEQ * 16; e += F.NGW * 64) { const int pos = e >> 4, i = e & 15;
          const float invf = 1.0f / powf(10000.0f, (float)i * 0.0625f); const float ang = (float)pos * invf; tab[e] = make_float2(cosf(ang), sinf(ang)); } }
    convert_wa(F, 0);
    cast_rows(F, F.inp(I_X), (bf16_t*)(F.ws + WS_HS), (unsigned char*)F.out, rsx_ptr(F, 0));
}
__device__ __forceinline__ float* rsq_ptr(Frame& F, int l, int kind) { return (float*)(F.ws + WS_RSQ) + ((size_t)l * 2 + kind) * M * 4; }

__device__ __forceinline__ void phase_g1(Frame& F, const int l) {
    {
        pg8::SchedTiles S{l == 0 ? (const bf16_t*)(F.ws + WS_HS) : (const bf16_t*)F.out + (size_t)M * DM, (const bf16_t*)(F.ws + WS_WIN), DM, DM, M / 256, NPS / 256, F.G, cur_bid()};
        pg8::EpiProj E{(bf16_t*)(F.ws + WS_PS), (bf16_t*)(F.ws + WS_GT), rsq_ptr(F, l, 0), rsq_ptr(F, l, 1), 1.0f, (const LAS float*)(F.lds + pg8::RSX_LDS)};
        {
            const int nb = ((M / 256) * (NPS / 256) + F.G - 1) / F.G, ng = ((M / 256) * (NGT / 256) + F.G - 1) / F.G + 1;
            pg8::SchedGateBal S2{(const bf16_t*)F.out, (const bf16_t*)(F.ws + WS_WG8), DM / 2, DM / 2, F.G, S.c, NPS / 256, nb};
            const int tid = cur_tid(F.wave); pg8::fill_rsx_lds(F.lds, tid, S, rsx_ptr(F, 0), nb); pg8::fill_rsx_lds(F.lds, tid, S2, rsx_ptr(F, 0), ng); }
        pg8::gemm_phase<pg8::EpiProj, pg8::SchedTiles, true, DM, DM, DM>(F.lds, F.wave, S, E);
    }
    frame_refresh(F);
    {
        pg8::SchedGateBal S{(const bf16_t*)F.out, (const bf16_t*)(F.ws + WS_WG8), DM / 2, DM / 2, F.G, cur_bid(), NPS / 256, ((M / 256) * (NPS / 256) + F.G - 1) / F.G};
        pg8::EpiProj E{(bf16_t*)(F.ws + WS_PS), (bf16_t*)(F.ws + WS_GT), rsq_ptr(F, l, 0), rsq_ptr(F, l, 1), 1.0f / 32.0f, (const LAS float*)(F.lds + pg8::RSX_LDS)};
        pg8::gemm_phase<pg8::EpiProj, pg8::SchedGateBal, true, DM / 2, DM / 2, DM / 2, true>(F.lds, F.wave, S, E);
    }
}
__device__ __forceinline__ void attn_ab(Frame& F, const int l);
__device__ __forceinline__ void attn_ab_fwd(Frame& F, const int l) { attn_ab(F, l); }
__device__ __forceinline__ void phase_prep(Frame& F, const int l) {
    {
        pg8::SchedDup S{(const bf16_t*)(F.ws + WS_PS), (const bf16_t*)(F.ws + WS_WDUP), F.G, cur_bid()};
        pg8::EpiDup E{(bf16_t*)(F.ws + WS_QD), (bf16_t*)(F.ws + WS_KD), (bf16_t*)(F.ws + WS_VD), rsq_ptr(F, l, 0), rsq_ptr(F, l, 1), (const float2*)(F.ws + WS_TAB), __builtin_bit_cast(float, __builtin_amdgcn_readfirstlane(0x358637bd))};
        pg8::gemm_phase<pg8::EpiDup, pg8::SchedDup, false, 384, NPS, 384, false, true>(F.lds, F.wave, S, E);
    }
    frame_refresh(F);
    bf16_t* PS = (bf16_t*)(F.ws + WS_PS); bf16_t* KD = (bf16_t*)(F.ws + WS_KD); const float2* tab = (const float2*)(F.ws + WS_TAB);
    const int lane = lane_id(); const bool isc = lane < 48, act = lane < 52; const int L = act ? lane : 51;
    const int hh = L >> 3, c = isc ? (L & 7) : (L - 48), half = isc ? (c >> 2) : 0, cc = c & 3; const bool lo = cc < 2;
    const int coff = isc ? (C_CQ + 64 * hh + 8 * c) : (C_DKR + 8 * c);
    float g[8];
    { const float* gp = (hh < 4 ? F.inp(I_CQN) : F.inp(I_CKN)) + l * 64 + 8 * (isc ? c : 0);
#pragma unroll
      for (int j = 0; j < 8; ++j) g[j] = gp[j]; }
    const int kp0 = 16 * (c & 1) + 4 * (c >> 1);
    for (int m0 = F.gw; m0 < M; m0 += 2 * F.NGW) {
        u32x4 xw[2];
#pragma unroll
        for (int r = 0; r < 2; ++r) xw[r] = *(const u32x4*)(PS + (size_t)(m0 + r * F.NGW) * NPS + coff);
#pragma unroll
        for (int r = 0; r < 2; ++r) { const int m = m0 + r * F.NGW, t = m & (SEQ - 1); const int pos = isc ? (half ? (t & 63) : (t >> 6)) : t;
            const float2* tp = tab + pos * 16 + 8 * (cc & 1);
            float x[8] = {bf_lo(xw[r].x), bf_hi(xw[r].x), bf_lo(xw[r].y), bf_hi(xw[r].y), bf_lo(xw[r].z), bf_hi(xw[r].z), bf_lo(xw[r].w), bf_hi(xw[r].w)};
            float s = 0.f;
#pragma unroll
            for (int j = 0; j < 8; ++j) s += x[j] * x[j];
            s += __shfl_xor(s, 1); s += __shfl_xor(s, 2); s += __shfl_xor(s, 4);
            const float rstd = isc ? __builtin_amdgcn_rsqf(s * (1.0f / 64.0f) + EPS) * (hh < 4 ? 0.125f * LOG2E : 1.0f) : 1.0f;
            float o[8];
#pragma unroll
            for (int j = 0; j < 8; ++j) { const float y = isc ? x[j] * rstd * g[j] : x[j]; const float yp = __shfl_xor(y, 2); const float2 cs = tp[j];
                o[j] = lo ? (y * cs.x - yp * cs.y) : (y * cs.x + yp * cs.y); }
            u32x4 w; w.x = cvt_pk_bf16(o[0], o[1]); w.y = cvt_pk_bf16(o[2], o[3]); w.z = cvt_pk_bf16(o[4], o[5]); w.w = cvt_pk_bf16(o[6], o[7]);
            if (isc) *(u32x4*)(PS + (size_t)m * NPS + coff) = w;
            else if (act) {
#pragma unroll
                for (int h = 0; h < 4; ++h) { bf16_t* kd = KD + (size_t)m * 384 + 96 * h + 64 + kp0; *(u32x2*)kd = (u32x2){w.x, w.y}; *(u32x2*)(kd + 8) = (u32x2){w.z, w.w}; } }
        }
    }
    frame_refresh(F); __syncthreads(); attn_ab_fwd(F, l);
}
__device__ __forceinline__ void attn_ab(Frame& F, const int l) {
    LAS char* lds = (LAS char*)F.lds; LAS float* tab = (LAS float*)(lds + att::L_TAB);
    for (int un = F.vcu; un < 256; un += F.G) {
        const int b = un >> 6, h = (un >> 4) & 3, qb = un & 15; const size_t rowb = (size_t)b * SEQ; const int q0 = qb * 256;
        { bf16_t* PS = (bf16_t*)(F.ws + WS_PS); const float* rpb = F.inp(I_RPB) + ((size_t)l * 4 + h) * 465;
          const int lane = lane_id(), wid = F.wave, tid = wid * 64 + lane, r32 = lane & 31, hi = lane >> 5;
          for (int e = tid; e < 1024; e += 512) { const int i = e - att::TSH_A; tab[e] = ((unsigned)i < 465u) ? rpb[i] * LOG2E : 0.f; }
          __syncthreads();
          const int R = 4 * qb + (wid >> 1), col = 32 * (wid & 1) + r32; const int rs = min(max(R - 4, 0), 56), cs = min(max(col - 8, 0), 48); const int rstart = min(max(4 * qb - 4, 0), 52);
          att::MP mp; mp.ib = 4 * hi - col; mp.colb = 4 * hi - cs; mp.R = R; mp.rs = rs; mp.rstart = rstart; mp.jlo = rs - rstart; mp.jhi = rs - rstart + 8;
          att::attn_unit<64, 2>(PS + (rowb + q0) * NPS + C_AQ + h * 64, NPS, PS + rowb * NPS + C_AK + h * 64, NPS, PS + rowb * NPS + C_AV + h * 64, NPS,
                                PS + (rowb + q0) * NPS + C_AQ + h * 64, NPS, rstart * 64, 12, 0.f, 0.f, mp, lds, F.wave); }
        { bf16_t* PS = (bf16_t*)(F.ws + WS_PS); const float* t5 = F.inp(I_T5);
          const int lane = lane_id(), wid = F.wave, tid = wid * 64 + lane, r32 = lane & 31, hi = lane >> 5;
          for (int e = tid; e < 1024; e += 512) { const int i = e - att::TSH_B; const int rel = i - 128, n = rel < 0 ? -rel : rel;
              const int lg = n >= 91 ? 15 : n >= 64 ? 14 : n >= 46 ? 13 : n >= 32 ? 12 : n >= 23 ? 11 : n >= 16 ? 10 : n >= 12 ? 9 : 8; const int bk = (rel > 0 ? 16 : 0) + (n < 8 ? n : lg);
              tab[e] = ((unsigned)i <= 256u) ? t5[bk * 4 + h] * LOG2E : att::NEG; }
          __syncthreads();
          const int kstart = max(0, q0 - 128), kend = min(SEQ, q0 + 384); const int t = q0 + 32 * wid + r32;
          att::MP mp; mp.ib = 128 - t + 4 * hi + kstart; mp.colb = 0; mp.R = 0; mp.rs = 0; mp.rstart = 0;
          { const int t0 = q0 + 32 * wid; mp.jlo = (max(kstart, t0 - 128) - kstart) >> 6; mp.jhi = ((min(kend - 1, t0 + 159) - kstart) >> 6) + 1; }
          const float sink2 = F.inp(I_SINK)[l * 4 + h] * LOG2E; const int hkv = h >> 1;
          att::attn_unit<64, 1>(PS + (rowb + q0) * NPS + C_BQ + h * 64, NPS, PS + rowb * NPS + C_BK + hkv * 64, NPS, PS + rowb * NPS + C_BV + hkv * 64, NPS,
                                PS + (rowb + q0) * NPS + C_BQ + h * 64, NPS, kstart, (kend - kstart) / 64, sink2, 1.0f, mp, lds, F.wave); }
    }
}
__device__ __forceinline__ void phase_attn(Frame& F, const int l) {
    LAS char* lds = (LAS char*)F.lds; LAS float* tab = (LAS float*)(lds + att::L_TAB);
    for (int un = F.vcu; un < 256; un += F.G) {
        const int b = un >> 6, h = (un >> 4) & 3, qb = un & 15; const size_t rowb = (size_t)b * SEQ; const int q0 = qb * 256;
        { bf16_t* PS = (bf16_t*)(F.ws + WS_PS); att::MP mp; mp.ib = 0; mp.colb = 0; mp.R = 0; mp.rs = 0; mp.rstart = 0; mp.jlo = 0; mp.jhi = 0; const int hkv = h >> 1;
          att::attn_unit<64, 0>(PS + (rowb + q0) * NPS + C_CQ + h * 64, NPS, PS + rowb * NPS + C_CK + hkv * 64, NPS, PS + rowb * NPS + C_CV + hkv * 64, NPS,
                                PS + (rowb + q0) * NPS + C_CQ + h * 64, NPS, 0, SEQ / 64, 0.f, 0.f, mp, lds, F.wave); }
        { bf16_t* PS = (bf16_t*)(F.ws + WS_PS); const bf16_t* QD = (const bf16_t*)(F.ws + WS_QD); const bf16_t* KD = (const bf16_t*)(F.ws + WS_KD); const bf16_t* VD = (const bf16_t*)(F.ws + WS_VD);
          att::MP mp; mp.ib = 0; mp.colb = 0; mp.R = 0; mp.rs = 0; mp.rstart = 0; mp.jlo = 0; mp.jhi = 0;
          att::attn_unit<96, 0>(QD + (rowb + q0) * 384 + h * 96, 384, KD + rowb * 384 + h * 96, 384, VD + rowb * 256 + h * 64, 256,
                                PS + (rowb + q0) * NPS + C_DCQ + h * 64, NPS, 0, SEQ / 64, 0.f, 0.f, mp, lds, F.wave); }
    }
}
__device__ __forceinline__ void phase_g3(Frame& F, const int l) {
    pg8::SchedBranch S{(const bf16_t*)(F.ws + WS_PS), (const bf16_t*)(F.ws + WS_WBR), F.G, cur_bid()};
    pg8::gemm_g3(F.lds, F.wave, S, (const char*)(F.ws + WS_GT), (bf16_t*)(F.ws + WS_HS));
}
__device__ __forceinline__ void phase_g4(Frame& F, const int l) {
    pg8::SchedTiles S{(const bf16_t*)(F.ws + WS_HS), (const bf16_t*)(F.ws + WS_WOUT), DM, DM, M / 256, 4, F.G, cur_bid()};
    pg8::EpiOutSq E{(bf16_t*)(F.ws + WS_MO)};
    pg8::gemm_phase<pg8::EpiOutSq, pg8::SchedTiles, false, DM, DM, DM>(F.lds, F.wave, S, E);
}
__device__ __forceinline__ void phase_n1(Frame& F, const int l) {
    convert_wb(F, l);
    const bf16_t* Y = (const bf16_t*)(F.ws + WS_MO); const float* gp = F.inp(I_LPOM) + l * DM;
    if (l == 0) resid_rows<false, true>(F, F.inp(I_X), F.ws + WS_XS, Y, gp, nullptr, rsx_ptr(F, 1));
    else resid_rows<true, true>(F, (const bf16_t*)F.out + (size_t)M * DM, F.ws + WS_XS, Y, gp, nullptr, rsx_ptr(F, 1));
}
__device__ __forceinline__ void phase_g5(Frame& F, const int l) {
    pg8::SchedTiles S{(const bf16_t*)(F.ws + WS_XS), (const bf16_t*)(F.ws + WS_WGU), DM, DM, M / 256, NGU / 256, F.G, cur_bid()};
    pg8::EpiSwiglu E{(bf16_t*)(F.ws + WS_ACT), (const LAS float*)(F.lds + pg8::RSX_LDS)};
    { pg8::fill_rsx_lds(F.lds, cur_tid(F.wave), S, rsx_ptr(F, 1), ((M / 256) * (NGU / 256) + F.G - 1) / F.G); }
    pg8::gemm_phase<pg8::EpiSwiglu, pg8::SchedTiles, true, DM, DM, DM>(F.lds, F.wave, S, E);
    if (l + 1 < DEPTH) { constexpr int nunits = (M / 256) * (NGU / 256); const int c = cur_bid(), G = F.G; const int nheavy = nunits % G;
        if (nheavy > 0 && c >= nheavy) { frame_refresh(F); const int gw0 = F.gw, ngw0 = F.NGW; F.gw = (c - nheavy) * NWAVES + F.wave; F.NGW = (G - nheavy) * NWAVES; convert_wa(F, l + 1); F.gw = gw0; F.NGW = ngw0; }
        else if (nheavy == 0) { frame_refresh(F); convert_wa(F, l + 1); } }
}
__device__ __forceinline__ void phase_g6(Frame& F, const int l) {
    pg8::SchedTiles S{(const bf16_t*)(F.ws + WS_ACT), (const bf16_t*)(F.ws + WS_WDN), DFF, DFF, M / 256, 4, F.G, cur_bid()};
    pg8::EpiOutSq E{(bf16_t*)(F.ws + WS_FO)};
    pg8::gemm_phase<pg8::EpiOutSq, pg8::SchedTiles, false, DFF, DFF, DFF>(F.lds, F.wave, S, E);
}
__device__ __forceinline__ void phase_n2(Frame& F, const int l) {
    const bf16_t* Y = (const bf16_t*)(F.ws + WS_FO); const float* gp = F.inp(I_LPOF) + l * DM;
    if (l == 0) resid_rows<true, true>(F, F.ws + WS_XS, (bf16_t*)F.out + (size_t)M * DM, Y, gp, (unsigned char*)F.out, rsx_ptr(F, 0));
    else resid_rows<true, false>(F, F.ws + WS_XS, F.out, Y, gp, nullptr, nullptr);
}

constexpr int NPHASE = 1 + 9 * DEPTH;
__global__ void __launch_bounds__(NWAVES * 64, 2) mega_fwd(Args args) {
    extern __shared__ __attribute__((aligned(16))) unsigned char lds[];
    Frame F;
    F.lds = (LAS unsigned char*)lds; F.ldsg = (char*)lds;
    F.G = gridDim.x; { const int bx = blockIdx.x; F.vcu = (F.G % 8 == 0) ? (bx % 8) * (F.G / 8) + bx / 8 : bx; }
    F.NGW = F.G * NWAVES; F.wave = __builtin_amdgcn_readfirstlane((int)threadIdx.x >> 6);
    const int lo = args.ph_lo, hi = args.ph_hi;
    volatile LAS unsigned* bst = (volatile LAS unsigned*)(F.lds + MISC_OFF);
    unsigned* bar = (unsigned*)(GAS unsigned*)(args.ws + WS_CTL) + CW_BAR;
    if (threadIdx.x == 0) { bst[0] = 0u; bst[1] = 0u; (void)xb_add(&bar[XB_XCNT(xb_xcc_id())], 1u); }
    __syncthreads();
#define GRID_BAR(ph) do { if (((ph) == 0 && MK_CG_FIRST) || MK_CG_BARRIER) { cg::this_grid().sync(); } else { unsigned* bar_ = (unsigned*)(F.ws + WS_CTL) + CW_BAR; \
        xcd_barrier(bar_, (volatile LAS unsigned*)(F.lds + MISC_OFF), F.wave == 0 && lane_id() == 0, (unsigned)F.G); } } while (0)
#define RUN_PHASE(ph, call) if (lo <= (ph) && (ph) < hi) { frame_refresh(F); call; if ((ph) + 1 < hi) { frame_refresh(F); GRID_BAR(ph); } }
    RUN_PHASE(0, phase_p0(F));
    RUN_PHASE(1, phase_g1(F, 0));  RUN_PHASE(2, phase_prep(F, 0));  RUN_PHASE(3, phase_attn(F, 0));  RUN_PHASE(4, phase_g3(F, 0));  RUN_PHASE(5, phase_g4(F, 0));
    RUN_PHASE(6, phase_n1(F, 0));  RUN_PHASE(7, phase_g5(F, 0));    RUN_PHASE(8, phase_g6(F, 0));    RUN_PHASE(9, phase_n2(F, 0));
    RUN_PHASE(10, phase_g1(F, 1)); RUN_PHASE(11, phase_prep(F, 1)); RUN_PHASE(12, phase_attn(F, 1)); RUN_PHASE(13, phase_g3(F, 1)); RUN_PHASE(14, phase_g4(F, 1));
    RUN_PHASE(15, phase_n1(F, 1)); RUN_PHASE(16, phase_g5(F, 1));   RUN_PHASE(17, phase_g6(F, 1));   RUN_PHASE(18, phase_n2(F, 1));
#undef RUN_PHASE
#undef GRID_BAR
}


#ifndef DBG_STOP
#define DBG_STOP 0
#endif
#if DBG_STOP
__global__ void dbg_fold(const bf16_t* b0, int p0, const bf16_t* b1, int p1, float* out) {
    const size_t i = (size_t)blockIdx.x * 256 + threadIdx.x; const int r = (int)(i >> 10), c = (int)(i & 1023); float s = 0.f;
    for (int j = 0; c + 1024 * j < p0; ++j) s += bf2f(b0[(size_t)r * p0 + c + 1024 * j]);
    if (b1) for (int j = 0; c + 1024 * j < p1; ++j) s += bf2f(b1[(size_t)r * p1 + c + 1024 * j]);
    out[i] = s;
}
#endif
extern "C" void kernel_launch(void* const* d_in, const int* in_sizes, int n_in, void* d_out, int out_size, void* d_ws, size_t ws_size, hipStream_t stream) {
    static int grid = 0;
    if (grid == 0) {
        if (n_in != 19 || in_sizes[0] != M * DM || out_size != M * DM || ws_size < WS_END) { fprintf(stderr, "kernel_launch: unexpected shapes (n_in %d, in0 %d, out %d, ws %zu)\n", n_in, n_in > 0 ? in_sizes[0] : -1, out_size, ws_size); grid = -1; return; }
        int dev = 0, cus = 0, per_cu = 0;
        if (hipGetDevice(&dev) != hipSuccess || hipDeviceGetAttribute(&cus, hipDeviceAttributeMultiprocessorCount, dev) != hipSuccess) { grid = -1; return; }
        if (hipFuncSetAttribute((const void*)mega_fwd, hipFuncAttributeMaxDynamicSharedMemorySize, LDS_BYTES) != hipSuccess) { fprintf(stderr, "kernel_launch: hipFuncSetAttribute failed\n"); grid = -1; return; }
        if (hipOccupancyMaxActiveBlocksPerMultiprocessor(&per_cu, (const void*)mega_fwd, NWAVES * 64, LDS_BYTES) != hipSuccess || per_cu < 1) { fprintf(stderr, "kernel_launch: occupancy query says %d\n", per_cu); per_cu = 1; }
        (void)hipGetLastError();
        grid = cus * (per_cu < 1 ? 1 : 1);
    }
    if (grid < 0) return;
    (void)hipMemsetAsync((char*)d_ws + WS_CTL, 0, CTL_BYTES, stream);
    Args a{};
    for (int i = 0; i < 19; ++i) a.in[i] = (const float*)d_in[i];
    a.out = (float*)d_out; a.ws = (unsigned char*)d_ws;
#if DBG_STOP
    for (int ph = 0; ph < DBG_STOP; ++ph) { a.ph_lo = ph; a.ph_hi = ph + 1; hipLaunchKernelGGL(mega_fwd, dim3(grid), dim3(NWAVES * 64), LDS_BYTES, stream, a); }
    { const bf16_t* b0; int p0; const bf16_t* b1 = nullptr; int p1 = 0; char* w = (char*)d_ws;
      if (DBG_STOP == 1) { b0 = (const bf16_t*)(w + WS_HS); p0 = 1024; }
      else if (DBG_STOP == 2) { b0 = (const bf16_t*)(w + WS_PS); p0 = NPS; b1 = (const bf16_t*)(w + WS_GT); p1 = NGT; }
      else if (DBG_STOP == 3) { b0 = (const bf16_t*)(w + WS_PS); p0 = NPS; b1 = (const bf16_t*)(w + WS_HS); p1 = 1024; }
      else if (DBG_STOP == 4) { b0 = (const bf16_t*)(w + WS_PS); p0 = NPS; }
      else if (DBG_STOP == 5) { b0 = (const bf16_t*)(w + WS_GT); p0 = NGT; }
      else if (DBG_STOP == 6) { b0 = (const bf16_t*)(w + WS_MO); p0 = 1024; }
      else if (DBG_STOP == 7) { b0 = (const bf16_t*)(w + WS_HS); p0 = 1024; }
      else if (DBG_STOP == 8) { b0 = (const bf16_t*)(w + WS_ACT); p0 = DFF; }
      else { b0 = (const bf16_t*)(w + WS_FO); p0 = 1024; }
      hipLaunchKernelGGL(dbg_fold, dim3(M * DM / 256), dim3(256), 0, stream, b0, p0, b1, p1, (float*)d_out); }
#elif MK_PER_PHASE
    for (int ph = 0; ph < NPHASE; ++ph) { a.ph_lo = ph; a.ph_hi = ph + 1; hipLaunchKernelGGL(mega_fwd, dim3(grid), dim3(NWAVES * 64), LDS_BYTES, stream, a); }
#else
    a.ph_lo = 0; a.ph_hi = NPHASE;
    void* kargs[] = {&a};
    const hipError_t e = hipLaunchCooperativeKernel((const void*)mega_fwd, dim3(grid), dim3(NWAVES * 64), kargs, LDS_BYTES, stream);
    if (e != hipSuccess) fprintf(stderr, "kernel_launch: cooperative launch failed: %s (grid %d)\n", hipGetErrorString(e), grid);
#endif
}
```
